# Optimizing an MI355X kernel written in HIP

```python
import jax, jax.numpy as jnp
from jax import lax
import numpy as np

D_MODEL = 1024
BATCH = 2
SEQ = 8192
DEPTH = 1
DEC_BATCH = 1
DEC_SEQ = 16384
PAST_LEN = 128

GRID_W = 64
NA_HEADS = 16
NA_HEAD_DIM = 64
NA_WIDTH = NA_HEADS * NA_HEAD_DIM
NA_KH = 8
NA_KW = 16
RET_HEADS = 4
RET_KEY_DIM = D_MODEL // RET_HEADS
RET_VAL_DIM = 2 * RET_KEY_DIM
RET_QK_WIDTH = RET_HEADS * RET_KEY_DIM
RET_V_WIDTH = RET_HEADS * RET_VAL_DIM
RET_CHUNK = 128
ROPE_BASE = 10000.0
FFN_HIDDEN = ((8 * D_MODEL + 3 * 256 - 1) // (3 * 256)) * 256
IN_WIDTH = 3 * NA_WIDTH + 2 * RET_QK_WIDTH + 2 * RET_V_WIDTH + 2 * D_MODEL
N_MOD = 6
EPS = 1e-6

kernel_name = "hybrid_natten_retention_encoder"


def rmsnorm(x, g):
    xf = x.astype(jnp.float32)
    y = xf * lax.rsqrt(jnp.mean(xf * xf, axis=-1, keepdims=True) + EPS) * g.astype(jnp.float32)
    return y.astype(x.dtype)


def neighbourhood_attention(q, k, v, rpb):
    b, n, h, dh = q.shape
    rows = n // GRID_W
    kh = min(NA_KH, rows)
    kw = NA_KW
    q = q.reshape(b, rows, GRID_W, h, dh) * (dh ** -0.5)
    k = k.reshape(b, rows, GRID_W, h, dh)
    v = v.reshape(b, rows, GRID_W, h, dh)
    cols = np.arange(GRID_W)
    col_start = np.clip(cols - kw // 2, 0, GRID_W - kw)
    col_idx = col_start[:, None] + np.arange(kw)[None, :]
    col_rel = col_idx - cols[:, None] + (NA_KW - 1)
    col_bias = rpb[:, :, col_rel].astype(jnp.float32)

    def row_block(r):
        rs = jnp.clip(r - kh // 2, 0, rows - kh)
        kr = lax.dynamic_slice_in_dim(k, rs, kh, axis=1)
        vr = lax.dynamic_slice_in_dim(v, rs, kh, axis=1)
        kg = kr[:, :, col_idx]
        vg = vr[:, :, col_idx]
        qr = lax.dynamic_index_in_dim(q, r, axis=1, keepdims=False)
        s = jnp.einsum('bchd,bicjhd->bhcij', qr, kg, preferred_element_type=jnp.float32)
        row_rel = rs + jnp.arange(kh) - r + (NA_KH - 1)
        bias = jnp.take(col_bias, row_rel, axis=1)
        s = s + bias.transpose(0, 2, 1, 3)[None]
        p = jax.nn.softmax(s.reshape(b, h, GRID_W, kh * kw), axis=-1).reshape(b, h, GRID_W, kh, kw)
        return jnp.einsum('bhcij,bicjhd->bchd', p.astype(v.dtype), vg)

    out = lax.map(row_block, jnp.arange(rows))
    return out.transpose(1, 0, 2, 3, 4).reshape(b, n, h * dh)


def rotary(x, pos):
    d = x.shape[-1]
    half = d // 2
    inv = 1.0 / (ROPE_BASE ** (jnp.arange(half, dtype=jnp.float32) / half))
    ang = pos[:, None] * inv[None, :]
    cos, sin = jnp.cos(ang), jnp.sin(ang)
    x1, x2 = x[..., :half], x[..., half:]
    return jnp.concatenate([x1 * cos - x2 * sin, x1 * sin + x2 * cos], axis=-1)


def retention_direction(q, k, v, log_gamma, strict):
    b, h, n, dk = q.shape
    dv = v.shape[-1]
    c = RET_CHUNK
    nc = n // c
    pos = jnp.arange(c, dtype=jnp.float32)
    rel = pos[:, None] - pos[None, :]
    mask = rel > 0 if strict else rel >= 0
    lg = log_gamma[:, None, None]
    dmat = jnp.where(mask[None], jnp.exp(jnp.where(mask, rel, 0.0)[None] * lg), 0.0)
    xi = jnp.exp((pos + 1.0)[None, :] * log_gamma[:, None])[None, :, :, None]
    zeta = jnp.exp((c - 1.0 - pos)[None, :] * log_gamma[:, None])[None, :, :, None]
    chunk_decay = jnp.exp(c * log_gamma)[None, :, None, None]

    def to_chunks(t):
        return t.reshape(b, h, nc, c, t.shape[-1]).transpose(2, 0, 1, 3, 4)

    def step(state, xs):
        qc, kc, vc = xs
        scores = jnp.einsum('bhqd,bhkd->bhqk', qc, kc) * dmat[None]
        intra = jnp.einsum('bhqk,bhkv->bhqv', scores, vc)
        cross = jnp.einsum('bhqd,bhdv->bhqv', qc, state) * xi
        new_state = state * chunk_decay + jnp.einsum('bhkd,bhkv->bhdv', kc * zeta, vc)
        return new_state, intra + cross

    state0 = jnp.zeros((b, h, dk, dv), jnp.float32)
    _, out = lax.scan(step, state0, (to_chunks(q), to_chunks(k), to_chunks(v)))
    return out.transpose(1, 2, 0, 3, 4).reshape(b, h, n, dv)


def bidirectional_retention(q, k, v, decay_logit, gn_gain):
    b, n, h, dk = q.shape
    pos = jnp.arange(n, dtype=jnp.float32)
    qf = rotary(q.astype(jnp.float32).transpose(0, 2, 1, 3), pos)
    kf = rotary(k.astype(jnp.float32).transpose(0, 2, 1, 3), pos) * (dk ** -0.5)
    vf = v.astype(jnp.float32).transpose(0, 2, 1, 3)
    lg = jax.nn.log_sigmoid(decay_logit.astype(jnp.float32))
    fwd = retention_direction(qf, kf, vf, lg[0], False)
    bwd = jnp.flip(retention_direction(jnp.flip(qf, 2), jnp.flip(kf, 2), jnp.flip(vf, 2), lg[1], True), 2)
    y = fwd + bwd
    mu = jnp.mean(y, axis=-1, keepdims=True)
    var = jnp.mean(jnp.square(y - mu), axis=-1, keepdims=True)
    y = (y - mu) * lax.rsqrt(var + EPS)
    y = y.transpose(0, 2, 1, 3).reshape(b, n, h * y.shape[-1]) * gn_gain.astype(jnp.float32)
    return y.astype(q.dtype)


def encoder_layer(x, c, w_mod, b_mod, g_pre_mix, w_in, rpb, ret_decay_logit, ret_gn,
                  w_up_na, w_up_ret, w_out, g_post_mix, g_pre_ffn, w_ffn_in, w_ffn_out, g_post_ffn):
    b, n, d = x.shape
    mod = jnp.dot(jax.nn.silu(c), w_mod) + b_mod
    sh1, sc1, gt1, sh2, sc2, gt2 = [m[:, None, :] for m in jnp.split(mod, N_MOD, axis=-1)]

    h = rmsnorm(x, g_pre_mix) * (1.0 + sc1) + sh1
    proj = jnp.dot(h, w_in)
    cuts = list(np.cumsum([NA_WIDTH, NA_WIDTH, NA_WIDTH, RET_QK_WIDTH, RET_QK_WIDTH,
                           RET_V_WIDTH, RET_V_WIDTH, D_MODEL])[:])
    na_q, na_k, na_v, r_q, r_k, r_v, r_g, g_na, g_ret = jnp.split(proj, cuts, axis=-1)
    y_na = neighbourhood_attention(na_q.reshape(b, n, NA_HEADS, NA_HEAD_DIM),
                                   na_k.reshape(b, n, NA_HEADS, NA_HEAD_DIM),
                                   na_v.reshape(b, n, NA_HEADS, NA_HEAD_DIM), rpb)
    y_ret = bidirectional_retention(r_q.reshape(b, n, RET_HEADS, RET_KEY_DIM),
                                    r_k.reshape(b, n, RET_HEADS, RET_KEY_DIM),
                                    r_v.reshape(b, n, RET_HEADS, RET_VAL_DIM),
                                    ret_decay_logit, ret_gn)
    y_ret = jax.nn.silu(r_g) * y_ret
    merged = jax.nn.sigmoid(g_na) * jnp.dot(y_na, w_up_na) + jax.nn.sigmoid(g_ret) * jnp.dot(y_ret, w_up_ret)
    out = jnp.dot(merged, w_out)
    x = x + gt1 * rmsnorm(out, g_post_mix)

    h = rmsnorm(x, g_pre_ffn) * (1.0 + sc2) + sh2
    a, gte = jnp.split(jnp.dot(h, w_ffn_in), 2, axis=-1)
    f = jnp.dot(jax.nn.silu(a) * gte, w_ffn_out)
    x = x + gt2 * rmsnorm(f, g_post_ffn)
    return x


def setup_inputs(seed: int = 0) -> dict:
    key = jax.random.key(seed)
    ks = jax.random.split(key, 24)
    f32 = jnp.float32

    def nrm(k, shape, scale):
        return jax.random.normal(k, shape, f32) * scale

    gammas = 1.0 - 2.0 ** (-5.0 - np.arange(RET_HEADS, dtype=np.float32))
    base_logit = jnp.asarray(np.log(gammas / (1.0 - gammas)), f32)
    decay_logit = base_logit[None, None, :] + nrm(ks[4], (DEPTH, 2, RET_HEADS), 0.1)
    return {
        "x_prompt": nrm(ks[0], (BATCH, SEQ, D_MODEL), 1.0),
        "x_sample": nrm(ks[1], (DEC_BATCH, DEC_SEQ, D_MODEL), 1.0),
        "c_prompt": nrm(ks[2], (BATCH, D_MODEL), 1.0),
        "c_sample": nrm(ks[3], (DEC_BATCH, D_MODEL), 1.0),
        "w_mod": nrm(ks[5], (DEPTH, D_MODEL, N_MOD * D_MODEL), 0.5 * D_MODEL ** -0.5),
        "b_mod": nrm(ks[6], (DEPTH, N_MOD * D_MODEL), 0.02),
        "g_pre_mix": 1.0 + nrm(ks[7], (DEPTH, D_MODEL), 0.05),
        "w_in": nrm(ks[8], (DEPTH, D_MODEL, IN_WIDTH), D_MODEL ** -0.5),
        "rpb": nrm(ks[9], (DEPTH, NA_HEADS, 2 * NA_KH - 1, 2 * NA_KW - 1), 0.5),
        "ret_decay_logit": decay_logit,
        "ret_gn": 1.0 + nrm(ks[10], (DEPTH, RET_V_WIDTH), 0.05),
        "w_up_na": nrm(ks[11], (DEPTH, NA_WIDTH, D_MODEL), NA_WIDTH ** -0.5),
        "w_up_ret": nrm(ks[12], (DEPTH, RET_V_WIDTH, D_MODEL), RET_V_WIDTH ** -0.5),
        "w_out": nrm(ks[13], (DEPTH, D_MODEL, D_MODEL), D_MODEL ** -0.5),
        "g_post_mix": 1.0 + nrm(ks[14], (DEPTH, D_MODEL), 0.05),
        "g_pre_ffn": 1.0 + nrm(ks[15], (DEPTH, D_MODEL), 0.05),
        "w_ffn_in": nrm(ks[16], (DEPTH, D_MODEL, 2 * FFN_HIDDEN), D_MODEL ** -0.5),
        "w_ffn_out": nrm(ks[17], (DEPTH, FFN_HIDDEN, D_MODEL), FFN_HIDDEN ** -0.5),
        "g_post_ffn": 1.0 + nrm(ks[18], (DEPTH, D_MODEL), 0.05),
    }


def reference(x_prompt, x_sample, c_prompt, c_sample, w_mod, b_mod, g_pre_mix, w_in, rpb,
              ret_decay_logit, ret_gn, w_up_na, w_up_ret, w_out, g_post_mix, g_pre_ffn,
              w_ffn_in, w_ffn_out, g_post_ffn):
    y_prompt = x_prompt
    y_sample = x_sample
    for l in range(DEPTH):
        layer_w = (w_mod[l], b_mod[l], g_pre_mix[l], w_in[l], rpb[l], ret_decay_logit[l], ret_gn[l],
                   w_up_na[l], w_up_ret[l], w_out[l], g_post_mix[l], g_pre_ffn[l], w_ffn_in[l],
                   w_ffn_out[l], g_post_ffn[l])
        y_prompt = encoder_layer(y_prompt, c_prompt, *layer_w)
        y_sample = encoder_layer(y_sample, c_sample, *layer_w)
    return (y_prompt, y_sample)
```

```cpp
#include <hip/hip_runtime.h>
#include <hip/hip_cooperative_groups.h>
#include <cstdio>
#include <cstdint>
__device__ const float INVT[128] = {1.591549367e-01f, 1.481051445e-01f, 1.378225088e-01f, 1.282537729e-01f, 1.193493679e-01f, 1.110631898e-01f, 1.033522934e-01f, 9.617675841e-02f, 8.949939907e-02f, 8.328563720e-02f, 7.750328630e-02f, 7.212239504e-02f, 6.711508334e-02f, 6.245541945e-02f, 5.811926723e-02f, 5.408416688e-02f, 5.032921210e-02f, 4.683495685e-02f, 4.358330369e-02f, 4.055740312e-02f, 3.774158657e-02f, 3.512126207e-02f, 3.268286586e-02f, 3.041376173e-02f, 2.830219641e-02f, 2.633723244e-02f, 2.450869232e-02f, 2.280710265e-02f, 2.122365311e-02f, 1.975013874e-02f, 1.837892644e-02f, 1.710291393e-02f, 1.591549441e-02f, 1.481051371e-02f, 1.378225069e-02f, 1.282537635e-02f, 1.193493698e-02f, 1.110631879e-02f, 1.033522934e-02f, 9.617676027e-03f, 8.949940093e-03f, 8.328564465e-03f, 7.750329096e-03f, 7.212239318e-03f, 6.711508147e-03f, 6.245541852e-03f, 5.811926909e-03f, 5.408416502e-03f, 5.032921210e-03f, 4.683495965e-03f, 4.358330276e-03f, 4.055740312e-03f, 3.774158424e-03f, 3.512126394e-03f, 3.268286586e-03f, 3.041376127e-03f, 2.830219688e-03f, 2.633723198e-03f, 2.450869186e-03f, 2.280710265e-03f, 2.122365171e-03f, 1.975013874e-03f, 1.837892574e-03f, 1.710291486e-03f, 1.591549488e-03f, 1.481051440e-03f, 1.378225046e-03f, 1.282537705e-03f, 1.193493721e-03f, 1.110631856e-03f, 1.033523004e-03f, 9.617675678e-04f, 8.949940093e-04f, 8.328563999e-04f, 7.750329096e-04f, 7.212239434e-04f, 6.711508031e-04f, 6.245541736e-04f, 5.811926676e-04f, 5.408416619e-04f, 5.032921326e-04f, 4.683495790e-04f, 4.358330334e-04f, 4.055740137e-04f, 3.774158540e-04f, 3.512126277e-04f, 3.268286528e-04f, 3.041376185e-04f, 2.830219455e-04f, 2.633723198e-04f, 2.450869069e-04f, 2.280710323e-04f, 2.122365258e-04f, 1.975013729e-04f, 1.837892632e-04f, 1.710291544e-04f, 1.591549371e-04f, 1.481051440e-04f, 1.378224988e-04f, 1.282537705e-04f, 1.193493736e-04f, 1.110631856e-04f, 1.033522931e-04f, 9.617675823e-05f, 8.949940093e-05f, 8.328563854e-05f, 7.750328950e-05f, 7.212239143e-05f, 6.711508468e-05f, 6.245542318e-05f, 5.811926894e-05f, 5.408416473e-05f, 5.032921035e-05f, 4.683495717e-05f, 4.358330261e-05f, 4.055740283e-05f, 3.774158540e-05f, 3.512126204e-05f, 3.268286673e-05f, 3.041376112e-05f, 2.830219637e-05f, 2.633723125e-05f, 2.450869215e-05f, 2.280710396e-05f, 2.122365186e-05f, 1.975013765e-05f, 1.837892523e-05f, 1.710291508e-05f};
namespace pg8 {
#define PG8_LAS __attribute__((address_space(3)))
typedef unsigned short bf16_t;
typedef short bf16x8 __attribute__((ext_vector_type(8)));
typedef float f32x4 __attribute__((ext_vector_type(4)));
typedef unsigned u32x4 __attribute__((ext_vector_type(4)));
constexpr int BM = 256, BK = 64, HALF = 128, HTB = HALF * BK * 2  , STAGE_BYTES = 8 * HTB, NXCD = 8, WGM = 8;

__host__ __device__ __forceinline__ int lds_byte(int r, int c) { const int st = (r >> 4) * 2 + (c >> 5), rr = r & 15, cc = c & 31, ob = rr * 64 + cc * 2; return st * 1024 + (ob ^ (((ob >> 9) & 1) << 5)); }
__host__ __device__ __forceinline__ void stage_rc(int b, int& R, int& C) { const int st = b / 1024, sb = b % 1024, swz = sb ^ (((sb >> 9) & 1) << 5); R = (st >> 1) * 16 + swz / 64; C = (st & 1) * 32 + (swz % 64) / 2; }
__host__ __device__ __forceinline__ int perm32(int rho) { const int n = rho >> 4, i = rho & 15; return 8 * (i >> 2) + 4 * n + (i & 3); }

struct Unit { int pm, pn; };
struct Gemm { const bf16_t* A; const bf16_t* Bt; int M, N, K; };

struct StaticOrder {
    int nM, nN, nwg, G, c;
    __host__ __device__ void init(int M, int N, int G_, int c_) { nM = M / BM; nN = N / BM; nwg = nM * nN; G = G_; c = c_; }
    __host__ __device__ bool next(int i, Unit& u) const {
        const long L = (long)i * G + c; if (L >= nwg) return false;
        int wgid = (int)L; { const int q = nwg / NXCD, r = nwg % NXCD, xcd = wgid % NXCD, off = wgid / NXCD; wgid = (xcd < r ? xcd * (q + 1) : r * (q + 1) + (xcd - r) * q) + off; }
        const int nig = WGM * nN, gid = wgid / nig, fm = gid * WGM, gsz = (nM - fm) < WGM ? (nM - fm) : WGM;
        u.pm = fm + ((wgid % nig) % gsz); u.pn = (wgid % nig) / gsz; return true;
    }
    __device__ __forceinline__ void a_ready(const Unit&) const {}
    __device__ __forceinline__ void done(const Unit&) const {}
};
__device__ __forceinline__ unsigned cvt_pk_bf16(float lo, float hi) { unsigned r; asm volatile("v_cvt_pk_bf16_f32 %0, %1, %2" : "=v"(r) : "v"(lo), "v"(hi)); return r; }
__device__ __forceinline__ float bflo(unsigned w) { return __uint_as_float(w << 16); }
__device__ __forceinline__ float bfhi(unsigned w) { return __uint_as_float(w & 0xffff0000u); }
__device__ __forceinline__ float sigm(float x) { return __builtin_amdgcn_rcpf(1.f + __expf(-x)); }
__device__ __forceinline__ void unpack8(const u32x4 w, float (&f)[8]) {
    f[0] = bflo(w.x); f[1] = bfhi(w.x); f[2] = bflo(w.y); f[3] = bfhi(w.y); f[4] = bflo(w.z); f[5] = bfhi(w.z); f[6] = bflo(w.w); f[7] = bfhi(w.w); }
__device__ __forceinline__ u32x4 pack8(const float (&f)[8]) {
    u32x4 w; w.x = cvt_pk_bf16(f[0], f[1]); w.y = cvt_pk_bf16(f[2], f[3]); w.z = cvt_pk_bf16(f[4], f[5]); w.w = cvt_pk_bf16(f[6], f[7]); return w; }

struct EpiF32 {
    static constexpr bool PERM = false, AFTER_DRAIN = false;
    float* C; int ldc;
    __device__ __forceinline__ void operator()(const f32x4 (&acc)[2][2][4][2], const Unit& u, int wr, int wc, int fr, int fq) const {
        const int row0 = u.pm * BM + wr * 64 + fr, col0 = u.pn * BM + wc * 32 + 4 * fq;
#pragma unroll
        for (int ai = 0; ai < 2; ++ai)
#pragma unroll
            for (int m = 0; m < 4; ++m) { float* rowp = C + (size_t)(row0 + ai * HALF + m * 16) * ldc + col0;
#pragma unroll
                for (int bj = 0; bj < 2; ++bj)
#pragma unroll
                    for (int n = 0; n < 2; ++n) *(f32x4*)(rowp + bj * HALF + n * 16) = acc[ai][bj][m][n]; }
    }
};

struct EpiBf {
    static constexpr bool PERM = true, AFTER_DRAIN = false;
    int mode; bf16_t *o0, *o1, *o2; const bf16_t *a1, *a2; int ldo, ld1, ld2, seqmask;
    __device__ __forceinline__ void operator()(const f32x4 (&acc)[2][2][4][2], const Unit& u, int wr, int wc, int fr, int fq) const {
        const int row0 = u.pm * BM + wr * 64 + fr, cin = wc * 32 + 8 * fq;
        if (mode == 1 && u.pn < 8) {
            bf16_t* base = (u.pn < 4) ? o0 : o1; const float sc = (u.pn < 4) ? 1.f : 0.0625f; const int hcol = (u.pn & 3) * 256 + cin;
            float it[8];
#pragma unroll
            for (int e = 0; e < 8; ++e) it[e] = INVT[cin + e];
#pragma unroll
            for (int ai = 0; ai < 2; ++ai)
#pragma unroll
                for (int m = 0; m < 4; ++m) { const int row = row0 + ai * HALF + m * 16; const float pos = (float)(row & seqmask);
                    float r1[8], r2[8];
#pragma unroll
                    for (int e = 0; e < 8; ++e) { const float x1 = acc[ai][0][m][e >> 2][e & 3], x2 = acc[ai][1][m][e >> 2][e & 3];
                        const float f = __builtin_amdgcn_fractf(pos * it[e]); const float s = __builtin_amdgcn_sinf(f), c = __builtin_amdgcn_cosf(f);
                        r1[e] = (x1 * c - x2 * s) * sc; r2[e] = (x1 * s + x2 * c) * sc; }
                    bf16_t* p = base + (size_t)row * 1024 + hcol;
                    *(u32x4*)p = pack8(r1); *(u32x4*)(p + 128) = pack8(r2); }
            return;
        }
        if (mode == 6) {
            const int ocol = u.pn * 128 + cin;
#pragma unroll
            for (int ai = 0; ai < 2; ++ai)
#pragma unroll
                for (int m = 0; m < 4; ++m) { const int row = row0 + ai * HALF + m * 16; float r[8];
#pragma unroll
                    for (int e = 0; e < 8; ++e) { const float a = acc[ai][0][m][e >> 2][e & 3], g = acc[ai][1][m][e >> 2][e & 3]; r[e] = a * sigm(a) * g; }
                    *(u32x4*)(o0 + (size_t)row * ldo + ocol) = pack8(r); }
            return;
        }
        bf16_t* ob = o0; int ocol = u.pn * BM + cin, ld = ldo; float sc = 1.f;
        if (mode == 0) { const int t = u.pn >> 2; ob = (t == 0) ? o0 : ((t == 1) ? o1 : o2); ocol = (u.pn & 3) * 256 + cin; ld = 1024; sc = (t == 0) ? 0.125f : 1.f; }
        else if (mode == 1) { ob = o2; ocol = (u.pn - 8) * 256 + cin; ld = 2048; }
#pragma unroll
        for (int ai = 0; ai < 2; ++ai)
#pragma unroll
            for (int m = 0; m < 4; ++m) { const int row = row0 + ai * HALF + m * 16;
#pragma unroll
                for (int bj = 0; bj < 2; ++bj) { const int col = ocol + bj * HALF; float r[8];
#pragma unroll
                    for (int e = 0; e < 8; ++e) r[e] = acc[ai][bj][m][e >> 2][e & 3];
                    if (mode <= 1) {
#pragma unroll
                        for (int e = 0; e < 8; ++e) r[e] *= sc;
                    } else if (mode == 2) {
#pragma unroll
                        for (int e = 0; e < 8; ++e) r[e] = sigm(r[e]);
                    } else {
                        float x[8]; unpack8(*(const u32x4*)(a1 + (size_t)row * ld1 + col), x);
                        if (mode == 3) {
#pragma unroll
                            for (int e = 0; e < 8; ++e) r[e] = r[e] * sigm(r[e]) * x[e];
                        } else if (mode == 4) {
#pragma unroll
                            for (int e = 0; e < 8; ++e) r[e] = r[e] * x[e];
                        } else {
                            float y[8]; unpack8(*(const u32x4*)(a2 + (size_t)row * ld2 + col), y);
#pragma unroll
                            for (int e = 0; e < 8; ++e) r[e] = y[e] + r[e] * x[e];
                        }
                    }
                    *(u32x4*)(ob + (size_t)row * ld + col) = pack8(r); } }
    }
};

template <class Epi, class Sched, bool ALIGN_EPI = false, bool SP2 = false>
__device__ __forceinline__ void gemm_phase(PG8_LAS unsigned char* lds, const Gemm g, const Sched& S, const Epi& E) {
    const int tid = threadIdx.x, wid = __builtin_amdgcn_readfirstlane(tid >> 6), lane = tid & 63, wr = wid >> 2, wc = wid & 3, fr = lane & 15, fq = lane >> 4;
    const int K = g.K, nt = K / BK;
    unsigned voffA[2], voffB[2];
#pragma unroll
    for (int i = 0; i < 2; ++i) { int R, C; stage_rc(tid * 16 + i * 8192, R, C); const int Rb = Epi::PERM ? ((R & ~31) + perm32(R & 31)) : R;
        voffA[i] = (unsigned)(R * K + C) * 2u; voffB[i] = (unsigned)(Rb * K + C) * 2u; }
    const size_t kstep = (size_t)(BK * 2);
    const size_t hstep = (size_t)HALF * K * 2;
    const size_t tstep = 2 * hstep;
    const unsigned ldsw = (unsigned)wid * 1024u;
    const int aoff = lds_byte(wr * 64 + fr, fq * 8), boff = lds_byte(wc * 32 + fr, fq * 8);
#define PG8_SA(b, h) (((b) * 2 + (h)) * HTB)
#define PG8_SB(b, h) ((4 + (b) * 2 + (h)) * HTB)
#define PG8_STAGE(bufoff, gbase, voff) do { _Pragma("unroll") for (int _i = 0; _i < 2; ++_i) \
        __builtin_amdgcn_global_load_lds((const unsigned*)((const char*)(gbase) + (voff)[_i]), (PG8_LAS unsigned*)(lds + (bufoff) + ldsw + _i * 8192), 16, 0, 0); } while (0)
#define PG8_LDA(dst, b, h) do { _Pragma("unroll") for (int m = 0; m < 4; ++m) _Pragma("unroll") for (int k = 0; k < 2; ++k) dst[m][k] = *(const PG8_LAS bf16x8*)(lds + PG8_SA(b, h) + aoff + m * 2048 + k * 1024); } while (0)
#define PG8_LDB(dst, b, h) do { _Pragma("unroll") for (int n = 0; n < 2; ++n) _Pragma("unroll") for (int k = 0; k < 2; ++k) dst[n][k] = *(const PG8_LAS bf16x8*)(lds + PG8_SB(b, h) + boff + n * 2048 + k * 1024); } while (0)
#define PG8_MMA(ai, bj, At, Bt) do { __builtin_amdgcn_s_setprio(1); _Pragma("unroll") for (int m = 0; m < 4; ++m) _Pragma("unroll") for (int n = 0; n < 2; ++n) _Pragma("unroll") for (int k = 0; k < 2; ++k) \
        acc[ai][bj][m][n] = __builtin_amdgcn_mfma_f32_16x16x32_bf16(Bt[n][k], At[m][k], acc[ai][bj][m][n], 0, 0, 0); __builtin_amdgcn_s_setprio(0); } while (0)
#define PG8_WAIT_V(n) asm volatile("s_waitcnt vmcnt(" #n ")" ::: "memory")
#define PG8_WAIT_L(n) asm volatile("s_waitcnt lgkmcnt(" #n ")" ::: "memory")
#define PG8_BAR __builtin_amdgcn_s_barrier()
#define PG8_SCHED __builtin_amdgcn_sched_barrier(0)
    Unit cur, nxt; int ui = 0;
    if (!S.next(0, cur)) return;
    f32x4 acc[2][2][4][2];
#pragma unroll
    for (int a = 0; a < 2; ++a)
#pragma unroll
        for (int b = 0; b < 2; ++b)
#pragma unroll
            for (int m = 0; m < 4; ++m)
#pragma unroll
                for (int n = 0; n < 2; ++n) acc[a][b][m][n] = (f32x4){0.f, 0.f, 0.f, 0.f};
    bf16x8 At[4][2], B0[2][2], B1[2][2];
    const char* cA = (const char*)g.A + (size_t)cur.pm * tstep; const char* cB = (const char*)g.Bt + (size_t)cur.pn * tstep;
    S.a_ready(cur);
    if constexpr (SP2) {
        PG8_STAGE(PG8_SB(0, 0), cB, voffB); PG8_STAGE(PG8_SB(0, 1), cB + hstep, voffB); PG8_STAGE(PG8_SA(0, 0), cA, voffA); PG8_STAGE(PG8_SA(0, 1), cA + hstep, voffA);
        if (wr == 1) PG8_BAR;
        PG8_WAIT_V(2); PG8_BAR;
        PG8_STAGE(PG8_SB(1, 0), cB + kstep, voffB); PG8_STAGE(PG8_SA(1, 0), cA + kstep, voffA); PG8_STAGE(PG8_SB(1, 1), cB + hstep + kstep, voffB);
        PG8_WAIT_V(6); PG8_BAR;
    } else {
        PG8_STAGE(PG8_SB(0, 0), cB, voffB); PG8_STAGE(PG8_SA(0, 0), cA, voffA); PG8_STAGE(PG8_SB(0, 1), cB + hstep, voffB); PG8_STAGE(PG8_SA(0, 1), cA + hstep, voffA);
        if (wr == 1) PG8_BAR;
        PG8_WAIT_V(4); PG8_BAR;
        PG8_STAGE(PG8_SB(1, 0), cB + kstep, voffB); PG8_STAGE(PG8_SA(1, 0), cA + kstep, voffA); PG8_STAGE(PG8_SB(1, 1), cB + hstep + kstep, voffB);
        PG8_WAIT_V(6); PG8_BAR;
    }
    for (;;) {
        const bool has_next = S.next(ui + 1, nxt);
        const char* nA = has_next ? (const char*)g.A + (size_t)nxt.pm * tstep : cA; const char* nB = has_next ? (const char*)g.Bt + (size_t)nxt.pn * tstep : cB;
        for (int t = 0; t < nt; t += 2) {
            const bool last = (t == nt - 2);
            const char* a1 = cA + (size_t)(t + 1) * kstep;
            const char* a2 = last ? nA : cA + (size_t)(t + 2) * kstep; const char* b2 = last ? nB : cB + (size_t)(t + 2) * kstep;
            const char* a3 = a2 + kstep; const char* b3 = b2 + kstep;
            if (last && has_next) S.a_ready(nxt);
            if constexpr (SP2) {
            PG8_LDB(B0, 0, 0); PG8_LDB(B1, 0, 1); PG8_SCHED; PG8_LDA(At, 0, 0); PG8_STAGE(PG8_SA(1, 1), a1 + hstep, voffA);
            PG8_WAIT_V(8); PG8_WAIT_L(0); PG8_BAR; PG8_MMA(0, 0, At, B0); PG8_MMA(0, 1, At, B1); PG8_BAR; PG8_SCHED;
            PG8_LDA(At, 0, 1); PG8_STAGE(PG8_SB(0, 0), b2, voffB); PG8_STAGE(PG8_SB(0, 1), b2 + hstep, voffB); PG8_STAGE(PG8_SA(0, 0), a2, voffA);
            PG8_WAIT_V(8); PG8_WAIT_L(0); PG8_BAR; PG8_MMA(1, 0, At, B0); PG8_MMA(1, 1, At, B1); PG8_BAR; PG8_SCHED;
            PG8_LDB(B0, 1, 0); PG8_LDB(B1, 1, 1); PG8_SCHED; PG8_LDA(At, 1, 0); PG8_STAGE(PG8_SA(0, 1), a2 + hstep, voffA);
            PG8_WAIT_V(8); PG8_WAIT_L(0); PG8_BAR; PG8_MMA(0, 0, At, B0); PG8_MMA(0, 1, At, B1); PG8_BAR; PG8_SCHED;
            PG8_LDA(At, 1, 1); PG8_STAGE(PG8_SB(1, 0), b3, voffB); PG8_STAGE(PG8_SB(1, 1), b3 + hstep, voffB); PG8_STAGE(PG8_SA(1, 0), a3, voffA);
            PG8_WAIT_V(8); PG8_WAIT_L(0); PG8_BAR; PG8_MMA(1, 0, At, B0); PG8_MMA(1, 1, At, B1); PG8_BAR; PG8_SCHED;
            } else {
            PG8_LDB(B0, 0, 0); PG8_SCHED; PG8_LDA(At, 0, 0); PG8_STAGE(PG8_SA(1, 1), a1 + hstep, voffA);
            PG8_WAIT_L(8); PG8_BAR; PG8_WAIT_L(0); PG8_MMA(0, 0, At, B0); PG8_BAR; PG8_SCHED;
            PG8_LDB(B1, 0, 1); PG8_STAGE(PG8_SB(0, 0), b2, voffB);
            PG8_BAR; PG8_WAIT_L(0); PG8_MMA(0, 1, At, B1); PG8_BAR;
            PG8_LDA(At, 0, 1); PG8_STAGE(PG8_SA(0, 0), a2, voffA);
            PG8_BAR; PG8_WAIT_L(0); PG8_MMA(1, 0, At, B0); PG8_BAR; PG8_SCHED;
            PG8_STAGE(PG8_SB(0, 1), b2 + hstep, voffB);
            PG8_WAIT_V(6); PG8_BAR; PG8_MMA(1, 1, At, B1); PG8_BAR;
            PG8_LDB(B0, 1, 0); PG8_SCHED; PG8_LDA(At, 1, 0); PG8_STAGE(PG8_SA(0, 1), a2 + hstep, voffA);
            PG8_WAIT_L(8); PG8_BAR; PG8_WAIT_L(0); PG8_MMA(0, 0, At, B0); PG8_BAR; PG8_SCHED;
            PG8_LDB(B1, 1, 1); PG8_STAGE(PG8_SB(1, 0), b3, voffB);
            PG8_BAR; PG8_WAIT_L(0); PG8_MMA(0, 1, At, B1); PG8_BAR;
            PG8_LDA(At, 1, 1); PG8_STAGE(PG8_SA(1, 0), a3, voffA);
            PG8_BAR; PG8_WAIT_L(0); PG8_MMA(1, 0, At, B0); PG8_BAR; PG8_SCHED;
            PG8_STAGE(PG8_SB(1, 1), b3 + hstep, voffB);
            PG8_WAIT_V(6); PG8_BAR; PG8_MMA(1, 1, At, B1); PG8_BAR;
            }
        }
        if constexpr (ALIGN_EPI) { if (wr == 0) PG8_BAR; }
        if constexpr (!Epi::AFTER_DRAIN) { E(acc, cur, wr, wc, fr, fq); S.done(cur); }
        if (!has_next) break;
#pragma unroll
        for (int a = 0; a < 2; ++a)
#pragma unroll
            for (int b = 0; b < 2; ++b)
#pragma unroll
                for (int m = 0; m < 4; ++m)
#pragma unroll
                    for (int n = 0; n < 2; ++n) acc[a][b][m][n] = (f32x4){0.f, 0.f, 0.f, 0.f};
        cur = nxt; cA = nA; cB = nB; ++ui;
        if constexpr (ALIGN_EPI) { if (wr == 1) PG8_BAR; }
    }
    PG8_WAIT_V(0);
    if constexpr (!ALIGN_EPI) { if (wr == 0) PG8_BAR; }
    PG8_BAR;
    if constexpr (Epi::AFTER_DRAIN) { E.fused(acc, cur, wr, wc, fr, fq, lds, wid, lane); S.done(cur); }
#undef PG8_SA
#undef PG8_SB
#undef PG8_STAGE
#undef PG8_LDA
#undef PG8_LDB
#undef PG8_MMA
#undef PG8_WAIT_V
#undef PG8_WAIT_L
#undef PG8_BAR
#undef PG8_SCHED
}
}
namespace cg = cooperative_groups;
#define LAS __attribute__((address_space(3)))
typedef unsigned short bf16;
typedef float f32x4 __attribute__((ext_vector_type(4)));
typedef unsigned u32x4 __attribute__((ext_vector_type(4)));
typedef unsigned u32x2 __attribute__((ext_vector_type(2)));

constexpr int NWAVES = 8, NTHREADS = 512;
constexpr int D = 1024, TP = 16384;
constexpr int FFN = 2816;
constexpr float EPS = 1e-6f;
constexpr int NSTEP = 14, NPHASE = 2 + 2 * NSTEP;
constexpr int LDS_BYTES = 147456;
#ifndef DIS_MASK
#define DIS_MASK 0
#endif
constexpr unsigned DIS = DIS_MASK;

constexpr size_t MiB = 1u << 20;
constexpr size_t WS_CTL = 0, WS_MODP = 64 * 1024, WS_MOD = 704 * 1024;
constexpr size_t WS_WIN = 1 * MiB, WS_WNA = 23 * MiB, WS_WRET = 25 * MiB, WS_WOUT = 29 * MiB, WS_WFI = 31 * MiB, WS_WFO = 42 * MiB;
constexpr size_t WS_H = 48 * MiB, WS_NQ = 80 * MiB, WS_O = 112 * MiB, WS_NK = 112 * MiB, WS_NV = 144 * MiB, WS_RV = 176 * MiB, WS_SG = 176 * MiB;
constexpr size_t WS_MERGED = 48 * MiB, WS_OUTMIX = 112 * MiB, WS_H2 = 80 * MiB, WS_ACT = 112 * MiB, WS_F = 48 * MiB, WS_END = 256 * MiB;

__device__ __forceinline__ float wave_sum(float v) {
#pragma unroll
    for (int o = 1; o < 64; o <<= 1) v += __shfl_xor(v, o);
    return v;
}
__device__ __forceinline__ float bf2f(unsigned short b) { return __uint_as_float((unsigned)b << 16); }
__device__ __forceinline__ unsigned pk2(float lo, float hi) { return pg8::cvt_pk_bf16(lo, hi); }
__device__ __forceinline__ float rdlane(float v, int l) { return __int_as_float(__builtin_amdgcn_readlane(__float_as_int(v), l)); }

__device__ __forceinline__ void transpose_item(const float* W, int K, int N, bf16* WT, int k0, int n0, int drow0, LAS float* scr, int lane) {
#pragma unroll 8
    for (int i = 0; i < 32; ++i) { const int kk = 2 * i + (lane >> 5); scr[kk * 33 + (lane & 31)] = W[(size_t)(k0 + kk) * N + n0 + (lane & 31)]; }
    asm volatile("s_waitcnt lgkmcnt(0)" ::: "memory");
    const int c = lane & 7;
#pragma unroll
    for (int j = 0; j < 4; ++j) { const int n = (lane >> 3) + 8 * j; const LAS float* s = scr + (8 * c) * 33 + n;
        u32x4 o; o.x = pk2(s[0 * 33], s[1 * 33]); o.y = pk2(s[2 * 33], s[3 * 33]); o.z = pk2(s[4 * 33], s[5 * 33]); o.w = pk2(s[6 * 33], s[7 * 33]);
        *(u32x4*)(WT + (size_t)(drow0 + n) * K + k0 + 8 * c) = o; }
    asm volatile("s_waitcnt lgkmcnt(0)" ::: "memory");
}

struct Args { const float* in[19]; float* out; unsigned char* ws; int ph_lo, ph_hi; };

__global__ void __launch_bounds__(NTHREADS, 2) fwd(Args args) {
    extern __shared__ __attribute__((aligned(16))) unsigned char lds_raw[];
    LAS unsigned char* lds = (LAS unsigned char*)lds_raw;
    for (int ph = args.ph_lo; ph < args.ph_hi; ++ph) {
    int tid = threadIdx.x; asm volatile("" : "+v"(tid));
    const int lane = tid & 63, wave = __builtin_amdgcn_readfirstlane(tid >> 6);
    const int G = gridDim.x, gw = blockIdx.x * NWAVES + wave, NGW = G * NWAVES;
    size_t zoff = 0; asm volatile("" : "+s"(zoff)); unsigned char* ws = args.ws + zoff;
    const float* x_prompt = args.in[0]; const float* x_sample = args.in[1]; const float* c_prompt = args.in[2]; const float* c_sample = args.in[3];
    const float* w_mod = args.in[4]; const float* b_mod = args.in[5]; const float* g_pre_mix = args.in[6]; const float* w_in = args.in[7];
    const float* rpb = args.in[8]; const float* decay_logit = args.in[9]; const float* ret_gn = args.in[10]; const float* w_up_na = args.in[11];
    const float* w_up_ret = args.in[12]; const float* w_out = args.in[13]; const float* g_post_mix = args.in[14]; const float* g_pre_ffn = args.in[15];
    const float* w_ffn_in = args.in[16]; const float* w_ffn_out = args.in[17]; const float* g_post_ffn = args.in[18];
    float* MODP = (float*)(ws + WS_MODP); float* MOD = (float*)(ws + WS_MOD);
    bf16* WIN = (bf16*)(ws + WS_WIN); bf16* WNA = (bf16*)(ws + WS_WNA); bf16* WRET = (bf16*)(ws + WS_WRET); bf16* WOUT = (bf16*)(ws + WS_WOUT);
    bf16* WFI = (bf16*)(ws + WS_WFI); bf16* WFO = (bf16*)(ws + WS_WFO);
    bf16* Hb = (bf16*)(ws + WS_H); bf16* NQ = (bf16*)(ws + WS_NQ); bf16* NK = (bf16*)(ws + WS_NK); bf16* NV = (bf16*)(ws + WS_NV);
    bf16* Ob = (bf16*)(ws + WS_O); bf16* RV = (bf16*)(ws + WS_RV); bf16* SG = (bf16*)(ws + WS_SG); bf16* MERGED = (bf16*)(ws + WS_MERGED);
    float* OUTMIX = (float*)(ws + WS_OUTMIX); bf16* H2 = (bf16*)(ws + WS_H2); bf16* ACT = (bf16*)(ws + WS_ACT); float* Fb = (float*)(ws + WS_F);
        if (ph == 0 && !(DIS & 1)) {
            LAS float* scr = (LAS float*)(lds + wave * 16384);
            constexpr int I_IN = 16 * 352, I_NA = 16 * 32, I_RET = 32 * 32, I_OUT = 16 * 32, I_FI = 16 * 176, I_FO = 44 * 32, I_MOD = 96 * 8;
            constexpr int NITEMS = I_IN + I_NA + I_RET + I_OUT + I_FI + I_FO + I_MOD;
            for (int it = gw; it < NITEMS; it += NGW) {
                int r = it;
                if (r < I_IN) { const int nb = r % 352, kb = r / 352; transpose_item(w_in, 1024, 11264, WIN, 64 * kb, 32 * nb, 32 * nb, scr, lane); continue; } r -= I_IN;
                if (r < I_NA) { const int nb = r % 32, kb = r / 32; transpose_item(w_up_na, 1024, 1024, WNA, 64 * kb, 32 * nb, 32 * nb, scr, lane); continue; } r -= I_NA;
                if (r < I_RET) { const int nb = r % 32, kb = r / 32; transpose_item(w_up_ret, 2048, 1024, WRET, 64 * kb, 32 * nb, 32 * nb, scr, lane); continue; } r -= I_RET;
                if (r < I_OUT) { const int nb = r % 32, kb = r / 32; transpose_item(w_out, 1024, 1024, WOUT, 64 * kb, 32 * nb, 32 * nb, scr, lane); continue; } r -= I_OUT;
                if (r < I_FI) { const int nb = r % 176, kb = r / 176; const int n0 = 32 * nb; const int j = (n0 < FFN) ? n0 : n0 - FFN;
                    const int drow = 256 * (j / 128) + (j % 128) + ((n0 < FFN) ? 0 : 128);
                    transpose_item(w_ffn_in, 1024, 2 * FFN, WFI, 64 * kb, n0, drow, scr, lane); continue; } r -= I_FI;
                if (r < I_FO) { const int nb = r % 32, kb = r / 32; transpose_item(w_ffn_out, FFN, 1024, WFO, 64 * kb, 32 * nb, 32 * nb, scr, lane); continue; } r -= I_FO;
                { const int strip = r % 96, kc = r / 96; const int j = strip * 64 + lane; float a0 = 0.f, a1 = 0.f, a2 = 0.f;
                    for (int k = kc * 128; k < kc * 128 + 128; ++k) { const float w = w_mod[(size_t)k * 6144 + j];
                        const float c0 = c_prompt[k], c1 = c_prompt[1024 + k], c2 = c_sample[k];
                        a0 += c0 * pg8::sigm(c0) * w; a1 += c1 * pg8::sigm(c1) * w; a2 += c2 * pg8::sigm(c2) * w; }
                    MODP[(kc * 3 + 0) * 6144 + j] = a0; MODP[(kc * 3 + 1) * 6144 + j] = a1; MODP[(kc * 3 + 2) * 6144 + j] = a2; }
            }
        } else if (ph == 1 && !(DIS & 2)) {
            for (int i = blockIdx.x * NTHREADS + tid; i < 3 * 6144; i += G * NTHREADS) { float s = b_mod[i % 6144];
#pragma unroll
                for (int kc = 0; kc < 8; ++kc) s += MODP[kc * 3 * 6144 + i];
                MOD[i] = s; }
        } else {
            const int pass = (ph - 2) / NSTEP, step = (ph - 2) % NSTEP;
            const float* xin = pass == 0 ? x_sample : x_prompt; float* outp = args.out + (pass == 0 ? (size_t)TP * D : 0);
            const int seqlen = pass == 0 ? 16384 : 8192, seq0 = pass == 0 ? 2 : 0, nseq = pass == 0 ? 1 : 2;
            bf16* RQ = (bf16*)outp; bf16* RK = RQ + (size_t)TP * 1024; bf16* TNA = RQ;
            if (step == 0 && !(DIS & 4)) {
                for (int t = gw; t < TP; t += NGW) { const float* mod = MOD + (size_t)(seq0 + t / seqlen) * 6144;
                    const f32x4* xr = (const f32x4*)(xin + (size_t)t * D) + lane; f32x4 v[4]; float ss = 0.f;
#pragma unroll
                    for (int j = 0; j < 4; ++j) { v[j] = xr[64 * j]; ss += (v[j].x * v[j].x + v[j].y * v[j].y) + (v[j].z * v[j].z + v[j].w * v[j].w); }
                    const float rstd = 1.0f / sqrtf(wave_sum(ss) * (1.f / D) + EPS);
                    u32x2* o8 = (u32x2*)(Hb + (size_t)t * D) + lane;
#pragma unroll
                    for (int j = 0; j < 4; ++j) { const int c = 4 * lane + 256 * j; const f32x4 g = *(const f32x4*)(g_pre_mix + c), sh = *(const f32x4*)(mod + c), sc = *(const f32x4*)(mod + 1024 + c);
                        const f32x4 h = v[j] * rstd * g * (sc + 1.0f) + sh; u32x2 w; w.x = pk2(h.x, h.y); w.y = pk2(h.z, h.w); o8[64 * j] = w; }
                }
            } else if ((step == 1 || step == 3 || step == 5 || step == 6 || step == 7 || step == 8 || step == 11) && !(DIS & 8)) {
                if (step == 5) {
                    for (int t = gw; t < TP; t += NGW) {
#pragma unroll
                        for (int h = 0; h < 4; ++h) { bf16* p = Ob + (size_t)t * 2048 + 512 * h + 8 * lane; float f[8]; pg8::unpack8(*(const u32x4*)p, f);
                            float s = 0.f;
#pragma unroll
                            for (int e = 0; e < 8; ++e) s += f[e];
                            const float mu = wave_sum(s) * (1.f / 512.f); float q = 0.f;
#pragma unroll
                            for (int e = 0; e < 8; ++e) { f[e] -= mu; q += f[e] * f[e]; }
                            const float rstd = 1.0f / sqrtf(wave_sum(q) * (1.f / 512.f) + EPS);
                            const f32x4 g0 = *(const f32x4*)(ret_gn + 512 * h + 8 * lane), g1 = *(const f32x4*)(ret_gn + 512 * h + 8 * lane + 4);
                            f[0] *= rstd * g0.x; f[1] *= rstd * g0.y; f[2] *= rstd * g0.z; f[3] *= rstd * g0.w; f[4] *= rstd * g1.x; f[5] *= rstd * g1.y; f[6] *= rstd * g1.z; f[7] *= rstd * g1.w;
                            *(u32x4*)p = pg8::pack8(f); }
                    }
                    __syncthreads();
                }
                pg8::Gemm g; pg8::EpiBf E; E.o1 = nullptr; E.o2 = nullptr; E.a1 = nullptr; E.a2 = nullptr; E.ldo = 1024; E.ld1 = 2048; E.ld2 = 1024; E.seqmask = seqlen - 1;
                if (step == 1)       { g = pg8::Gemm{Hb, WIN, TP, 3072, 1024}; E.mode = 0; E.o0 = NQ; E.o1 = NK; E.o2 = NV; }
                else if (step == 3)  { g = pg8::Gemm{Hb, WIN + (size_t)3072 * 1024, TP, 4096, 1024}; E.mode = 1; E.o0 = RQ; E.o1 = RK; E.o2 = RV; }
                else if (step == 5)  { g = pg8::Gemm{Hb, WIN + (size_t)9216 * 1024, TP, 2048, 1024}; E.mode = 2; E.o0 = SG; E.ldo = 2048; }
                else if (step == 6)  { g = pg8::Gemm{Hb, WIN + (size_t)7168 * 1024, TP, 2048, 1024}; E.mode = 3; E.o0 = Ob; E.ldo = 2048; E.a1 = Ob; E.ld1 = 2048; }
                else if (step == 7)  { g = pg8::Gemm{NQ, WNA, TP, 1024, 1024}; E.mode = 4; E.o0 = TNA; E.ldo = 1024; E.a1 = SG; E.ld1 = 2048; }
                else if (step == 8)  { g = pg8::Gemm{Ob, WRET, TP, 1024, 2048}; E.mode = 5; E.o0 = MERGED; E.ldo = 1024; E.a1 = SG + 1024; E.ld1 = 2048; E.a2 = TNA; E.ld2 = 1024; }
                else                 { g = pg8::Gemm{H2, WFI, TP, 2 * FFN, 1024}; E.mode = 6; E.o0 = ACT; E.ldo = FFN; }
                pg8::StaticOrder S; S.init(g.M, g.N, G, (int)blockIdx.x);
                pg8::gemm_phase<pg8::EpiBf, pg8::StaticOrder, true, true>(lds, g, S, E);
            } else if ((step == 9 || step == 12) && !(DIS & 16)) {
                pg8::Gemm g; pg8::EpiF32 E;
                if (step == 9) { g = pg8::Gemm{MERGED, WOUT, TP, 1024, 1024}; E.C = OUTMIX; E.ldc = 1024; }
                else           { g = pg8::Gemm{ACT, WFO, TP, 1024, FFN}; E.C = Fb; E.ldc = 1024; }
                pg8::StaticOrder S; S.init(g.M, g.N, G, (int)blockIdx.x);
                pg8::gemm_phase<pg8::EpiF32, pg8::StaticOrder, true, true>(lds, g, S, E);
            } else if (step == 2 && !(DIS & 32)) {
                const int rows = seqlen / 64;
                for (int un = blockIdx.x; un < 512; un += G) { const int R = un >> 1, h = (un & 1) * 8 + wave, c = lane, t = R * 64 + c;
                    const int r = R % rows, Rb = R - r; int rs = r - 4; rs = rs < 0 ? 0 : rs; rs = rs > rows - 8 ? rows - 8 : rs; int cs = c - 8; cs = cs < 0 ? 0 : cs; cs = cs > 48 ? 48 : cs;
                    float q[64], acc[64];
#pragma unroll
                    for (int i = 0; i < 8; ++i) { float f[8]; pg8::unpack8(*(const u32x4*)(NQ + (size_t)t * 1024 + 64 * h + 8 * i), f);
#pragma unroll
                        for (int e = 0; e < 8; ++e) { q[8 * i + e] = f[e]; acc[8 * i + e] = 0.f; } }
                    float mx = -INFINITY, l = 0.f;
                    for (int kr = 0; kr < 8; ++kr) for (int kc = 0; kc < 16; ++kc) { const int tk = (Rb + rs + kr) * 64 + cs + kc;
                        float s = rpb[(h * 15 + (rs + kr - r + 7)) * 31 + (cs + kc - c + 15)];
#pragma unroll
                        for (int i = 0; i < 8; ++i) { float f[8]; pg8::unpack8(*(const u32x4*)(NK + (size_t)tk * 1024 + 64 * h + 8 * i), f);
#pragma unroll
                            for (int e = 0; e < 8; ++e) s += q[8 * i + e] * f[e]; }
                        const float mn = fmaxf(mx, s), fo = __expf(mx - mn), p = __expf(s - mn); l = l * fo + p; mx = mn;
#pragma unroll
                        for (int i = 0; i < 8; ++i) { float f[8]; pg8::unpack8(*(const u32x4*)(NV + (size_t)tk * 1024 + 64 * h + 8 * i), f);
#pragma unroll
                            for (int e = 0; e < 8; ++e) acc[8 * i + e] = acc[8 * i + e] * fo + p * f[e]; } }
                    const float il = 1.0f / l;
#pragma unroll
                    for (int i = 0; i < 8; ++i) { float f[8];
#pragma unroll
                        for (int e = 0; e < 8; ++e) f[e] = acc[8 * i + e] * il;
                        *(u32x4*)(NQ + (size_t)t * 1024 + 64 * h + 8 * i) = pg8::pack8(f); }
                }
            } else if (step == 4 && !(DIS & 64)) {
                LAS float* red = (LAS float*)lds;
                for (int item = blockIdx.x; item < nseq * 32; item += G) { const int sq = item / 32, h = (item >> 3) & 3, sl = item & 7; const size_t tb = (size_t)sq * seqlen;
                    const int qoff = 256 * h + 32 * wave + (lane & 31), voff = 512 * h + 64 * sl + lane;
                    for (int dir = 0; dir < 2; ++dir) { const float lg = decay_logit[dir * 4 + h]; const float gam = 1.0f / (1.0f + expf(-lg));
                        float S[32];
#pragma unroll
                        for (int d = 0; d < 32; ++d) S[d] = 0.f;
                        for (int i = 0; i < seqlen; ++i) { const int n = dir == 0 ? i : seqlen - 1 - i; const size_t t = tb + n;
                            const float qv = bf2f(RQ[t * 1024 + qoff]), kv = bf2f(RK[t * 1024 + qoff]), v = bf2f(RV[t * 2048 + voff]); float part = 0.f;
                            if (dir == 0) {
#pragma unroll
                                for (int d = 0; d < 32; ++d) { S[d] = gam * S[d] + rdlane(kv, d) * v; part += rdlane(qv, d) * S[d]; }
                            } else {
#pragma unroll
                                for (int d = 0; d < 32; ++d) { part += rdlane(qv, d) * S[d]; S[d] = gam * (S[d] + rdlane(kv, d) * v); }
                            }
                            red[((i & 1) * 8 + wave) * 64 + lane] = part;
                            __syncthreads();
                            if (wave == 0) { float s = 0.f;
#pragma unroll
                                for (int w = 0; w < 8; ++w) s += red[((i & 1) * 8 + w) * 64 + lane];
                                bf16* op = Ob + t * 2048 + voff; if (dir == 1) s += bf2f(*op);
                                *op = (bf16)(pk2(s, 0.f) & 0xffffu); }
                        }
                        __syncthreads();
                    }
                }
            } else if (step == 10 && !(DIS & 128)) {
                for (int t = gw; t < TP; t += NGW) { const float* mod = MOD + (size_t)(seq0 + t / seqlen) * 6144;
                    const f32x4* orow = (const f32x4*)(OUTMIX + (size_t)t * D) + lane; const f32x4* xr = (const f32x4*)(xin + (size_t)t * D) + lane; f32x4 v[4]; float ss = 0.f;
#pragma unroll
                    for (int j = 0; j < 4; ++j) { v[j] = orow[64 * j]; ss += (v[j].x * v[j].x + v[j].y * v[j].y) + (v[j].z * v[j].z + v[j].w * v[j].w); }
                    const float rstd = 1.0f / sqrtf(wave_sum(ss) * (1.f / D) + EPS); float s2 = 0.f;
                    f32x4* o4 = (f32x4*)(outp + (size_t)t * D) + lane;
#pragma unroll
                    for (int j = 0; j < 4; ++j) { const int c = 4 * lane + 256 * j; const f32x4 g = *(const f32x4*)(g_post_mix + c), gt = *(const f32x4*)(mod + 2048 + c);
                        v[j] = xr[64 * j] + gt * (v[j] * rstd * g); o4[64 * j] = v[j]; s2 += (v[j].x * v[j].x + v[j].y * v[j].y) + (v[j].z * v[j].z + v[j].w * v[j].w); }
                    const float rstd2 = 1.0f / sqrtf(wave_sum(s2) * (1.f / D) + EPS);
                    u32x2* o8 = (u32x2*)(H2 + (size_t)t * D) + lane;
#pragma unroll
                    for (int j = 0; j < 4; ++j) { const int c = 4 * lane + 256 * j; const f32x4 g = *(const f32x4*)(g_pre_ffn + c), sh = *(const f32x4*)(mod + 3072 + c), sc = *(const f32x4*)(mod + 4096 + c);
                        const f32x4 h = v[j] * rstd2 * g * (sc + 1.0f) + sh; u32x2 w; w.x = pk2(h.x, h.y); w.y = pk2(h.z, h.w); o8[64 * j] = w; }
                }
            } else if (step == 13 && !(DIS & 256)) {
                for (int t = gw; t < TP; t += NGW) { const float* mod = MOD + (size_t)(seq0 + t / seqlen) * 6144;
                    const f32x4* frow = (const f32x4*)(Fb + (size_t)t * D) + lane; f32x4* o4 = (f32x4*)(outp + (size_t)t * D) + lane; f32x4 v[4]; float ss = 0.f;
#pragma unroll
                    for (int j = 0; j < 4; ++j) { v[j] = frow[64 * j]; ss += (v[j].x * v[j].x + v[j].y * v[j].y) + (v[j].z * v[j].z + v[j].w * v[j].w); }
                    const float rstd = 1.0f / sqrtf(wave_sum(ss) * (1.f / D) + EPS);
#pragma unroll
                    for (int j = 0; j < 4; ++j) { const int c = 4 * lane + 256 * j; const f32x4 g = *(const f32x4*)(g_post_ffn + c), gt = *(const f32x4*)(mod + 5120 + c);
                        o4[64 * j] = o4[64 * j] + gt * (v[j] * rstd * g); }
                }
            }
        }
    }
}

extern "C" void kernel_launch(void* const* d_in, const int* in_sizes, int n_in, void* d_out, int out_size, void* d_ws, size_t ws_size, hipStream_t stream) {
    static int grid = 0;
    if (grid == 0) {
        if (n_in != 19 || out_size != 2 * TP * D || ws_size < WS_END) { fprintf(stderr, "kernel_launch: unexpected shapes (n_in %d out %d ws %zu)\n", n_in, out_size, ws_size); grid = -1; return; }
        int dev = 0, cus = 0;
        if (hipGetDevice(&dev) != hipSuccess || hipDeviceGetAttribute(&cus, hipDeviceAttributeMultiprocessorCount, dev) != hipSuccess) { grid = -1; return; }
        if (hipFuncSetAttribute((const void*)fwd, hipFuncAttributeMaxDynamicSharedMemorySize, LDS_BYTES) != hipSuccess) { fprintf(stderr, "kernel_launch: hipFuncSetAttribute failed\n"); grid = -1; return; }
        grid = cus;
    }
    if (grid < 0) return;
    Args a{};
    for (int i = 0; i < 19; ++i) a.in[i] = (const float*)d_in[i];
    a.out = (float*)d_out; a.ws = (unsigned char*)d_ws;
    for (int ph = 0; ph < NPHASE; ++ph) { a.ph_lo = ph; a.ph_hi = ph + 1; hipLaunchKernelGGL(fwd, dim3(grid), dim3(NTHREADS), LDS_BYTES, stream, a); }
}
```

```cpp
#include <hip/hip_runtime.h>
#include <hip/hip_cooperative_groups.h>
#include <cstdio>
#include <cstdint>
__device__ const float INVT[128] = {1.591549367e-01f, 1.481051445e-01f, 1.378225088e-01f, 1.282537729e-01f, 1.193493679e-01f, 1.110631898e-01f, 1.033522934e-01f, 9.617675841e-02f, 8.949939907e-02f, 8.328563720e-02f, 7.750328630e-02f, 7.212239504e-02f, 6.711508334e-02f, 6.245541945e-02f, 5.811926723e-02f, 5.408416688e-02f, 5.032921210e-02f, 4.683495685e-02f, 4.358330369e-02f, 4.055740312e-02f, 3.774158657e-02f, 3.512126207e-02f, 3.268286586e-02f, 3.041376173e-02f, 2.830219641e-02f, 2.633723244e-02f, 2.450869232e-02f, 2.280710265e-02f, 2.122365311e-02f, 1.975013874e-02f, 1.837892644e-02f, 1.710291393e-02f, 1.591549441e-02f, 1.481051371e-02f, 1.378225069e-02f, 1.282537635e-02f, 1.193493698e-02f, 1.110631879e-02f, 1.033522934e-02f, 9.617676027e-03f, 8.949940093e-03f, 8.328564465e-03f, 7.750329096e-03f, 7.212239318e-03f, 6.711508147e-03f, 6.245541852e-03f, 5.811926909e-03f, 5.408416502e-03f, 5.032921210e-03f, 4.683495965e-03f, 4.358330276e-03f, 4.055740312e-03f, 3.774158424e-03f, 3.512126394e-03f, 3.268286586e-03f, 3.041376127e-03f, 2.830219688e-03f, 2.633723198e-03f, 2.450869186e-03f, 2.280710265e-03f, 2.122365171e-03f, 1.975013874e-03f, 1.837892574e-03f, 1.710291486e-03f, 1.591549488e-03f, 1.481051440e-03f, 1.378225046e-03f, 1.282537705e-03f, 1.193493721e-03f, 1.110631856e-03f, 1.033523004e-03f, 9.617675678e-04f, 8.949940093e-04f, 8.328563999e-04f, 7.750329096e-04f, 7.212239434e-04f, 6.711508031e-04f, 6.245541736e-04f, 5.811926676e-04f, 5.408416619e-04f, 5.032921326e-04f, 4.683495790e-04f, 4.358330334e-04f, 4.055740137e-04f, 3.774158540e-04f, 3.512126277e-04f, 3.268286528e-04f, 3.041376185e-04f, 2.830219455e-04f, 2.633723198e-04f, 2.450869069e-04f, 2.280710323e-04f, 2.122365258e-04f, 1.975013729e-04f, 1.837892632e-04f, 1.710291544e-04f, 1.591549371e-04f, 1.481051440e-04f, 1.378224988e-04f, 1.282537705e-04f, 1.193493736e-04f, 1.110631856e-04f, 1.033522931e-04f, 9.617675823e-05f, 8.949940093e-05f, 8.328563854e-05f, 7.750328950e-05f, 7.212239143e-05f, 6.711508468e-05f, 6.245542318e-05f, 5.811926894e-05f, 5.408416473e-05f, 5.032921035e-05f, 4.683495717e-05f, 4.358330261e-05f, 4.055740283e-05f, 3.774158540e-05f, 3.512126204e-05f, 3.268286673e-05f, 3.041376112e-05f, 2.830219637e-05f, 2.633723125e-05f, 2.450869215e-05f, 2.280710396e-05f, 2.122365186e-05f, 1.975013765e-05f, 1.837892523e-05f, 1.710291508e-05f};
namespace pg8 {
#define PG8_LAS __attribute__((address_space(3)))
typedef unsigned short bf16_t;
typedef short bf16x8 __attribute__((ext_vector_type(8)));
typedef float f32x4 __attribute__((ext_vector_type(4)));
typedef unsigned u32x4 __attribute__((ext_vector_type(4)));
constexpr int BM = 256, BK = 64, HALF = 128, HTB = HALF * BK * 2  , STAGE_BYTES = 8 * HTB, NXCD = 8, WGM = 8;

__host__ __device__ __forceinline__ int lds_byte(int r, int c) { const int st = (r >> 4) * 2 + (c >> 5), rr = r & 15, cc = c & 31, ob = rr * 64 + cc * 2; return st * 1024 + (ob ^ (((ob >> 9) & 1) << 5)); }
__host__ __device__ __forceinline__ void stage_rc(int b, int& R, int& C) { const int st = b / 1024, sb = b % 1024, swz = sb ^ (((sb >> 9) & 1) << 5); R = (st >> 1) * 16 + swz / 64; C = (st & 1) * 32 + (swz % 64) / 2; }
__host__ __device__ __forceinline__ int perm32(int rho) { const int n = rho >> 4, i = rho & 15; return 8 * (i >> 2) + 4 * n + (i & 3); }

struct Unit { int pm, pn; };
struct Gemm { const bf16_t* A; const bf16_t* Bt; int M, N, K; };

struct StaticOrder {
    int nM, nN, nwg, G, c;
    __host__ __device__ void init(int M, int N, int G_, int c_) { nM = M / BM; nN = N / BM; nwg = nM * nN; G = G_; c = c_; }
    __host__ __device__ bool next(int i, Unit& u) const {
        const long L = (long)i * G + c; if (L >= nwg) return false;
        int wgid = (int)L; { const int q = nwg / NXCD, r = nwg % NXCD, xcd = wgid % NXCD, off = wgid / NXCD; wgid = (xcd < r ? xcd * (q + 1) : r * (q + 1) + (xcd - r) * q) + off; }
        const int nig = WGM * nN, gid = wgid / nig, fm = gid * WGM, gsz = (nM - fm) < WGM ? (nM - fm) : WGM;
        u.pm = fm + ((wgid % nig) % gsz); u.pn = (wgid % nig) / gsz; return true;
    }
    __device__ __forceinline__ void a_ready(const Unit&) const {}
    __device__ __forceinline__ void done(const Unit&) const {}
};
__device__ __forceinline__ unsigned cvt_pk_bf16(float lo, float hi) { unsigned r; asm volatile("v_cvt_pk_bf16_f32 %0, %1, %2" : "=v"(r) : "v"(lo), "v"(hi)); return r; }
__device__ __forceinline__ float bflo(unsigned w) { return __uint_as_float(w << 16); }
__device__ __forceinline__ float bfhi(unsigned w) { return __uint_as_float(w & 0xffff0000u); }
__device__ __forceinline__ float sigm(float x) { return __builtin_amdgcn_rcpf(1.f + __expf(-x)); }
__device__ __forceinline__ void unpack8(const u32x4 w, float (&f)[8]) {
    f[0] = bflo(w.x); f[1] = bfhi(w.x); f[2] = bflo(w.y); f[3] = bfhi(w.y); f[4] = bflo(w.z); f[5] = bfhi(w.z); f[6] = bflo(w.w); f[7] = bfhi(w.w); }
__device__ __forceinline__ u32x4 pack8(const float (&f)[8]) {
    u32x4 w; w.x = cvt_pk_bf16(f[0], f[1]); w.y = cvt_pk_bf16(f[2], f[3]); w.z = cvt_pk_bf16(f[4], f[5]); w.w = cvt_pk_bf16(f[6], f[7]); return w; }

struct EpiF32 {
    static constexpr bool PERM = false, AFTER_DRAIN = false;
    float* C; int ldc;
    __device__ __forceinline__ void operator()(const f32x4 (&acc)[2][2][4][2], const Unit& u, int wr, int wc, int fr, int fq) const {
        const int row0 = u.pm * BM + wr * 64 + fr, col0 = u.pn * BM + wc * 32 + 4 * fq;
#pragma unroll
        for (int ai = 0; ai < 2; ++ai)
#pragma unroll
            for (int m = 0; m < 4; ++m) { float* rowp = C + (size_t)(row0 + ai * HALF + m * 16) * ldc + col0;
#pragma unroll
                for (int bj = 0; bj < 2; ++bj)
#pragma unroll
                    for (int n = 0; n < 2; ++n) *(f32x4*)(rowp + bj * HALF + n * 16) = acc[ai][bj][m][n]; }
    }
};

struct EpiBf {
    static constexpr bool PERM = true, AFTER_DRAIN = false;
    int mode; bf16_t *o0, *o1, *o2; const bf16_t *a1, *a2; int ldo, ld1, ld2, seqmask;
    __device__ __forceinline__ void operator()(const f32x4 (&acc)[2][2][4][2], const Unit& u, int wr, int wc, int fr, int fq) const {
        const int row0 = u.pm * BM + wr * 64 + fr, cin = wc * 32 + 8 * fq;
        if (mode == 1 && u.pn < 8) {
            bf16_t* base = (u.pn < 4) ? o0 : o1; const float sc = (u.pn < 4) ? 1.f : 0.0625f; const int hcol = (u.pn & 3) * 256 + cin;
            float it[8];
#pragma unroll
            for (int e = 0; e < 8; ++e) it[e] = INVT[cin + e];
#pragma unroll
            for (int ai = 0; ai < 2; ++ai)
#pragma unroll
                for (int m = 0; m < 4; ++m) { const int row = row0 + ai * HALF + m * 16; const float pos = (float)(row & seqmask);
                    float r1[8], r2[8];
#pragma unroll
                    for (int e = 0; e < 8; ++e) { const float x1 = acc[ai][0][m][e >> 2][e & 3], x2 = acc[ai][1][m][e >> 2][e & 3];
                        const float f = __builtin_amdgcn_fractf(pos * it[e]); const float s = __builtin_amdgcn_sinf(f), c = __builtin_amdgcn_cosf(f);
                        r1[e] = (x1 * c - x2 * s) * sc; r2[e] = (x1 * s + x2 * c) * sc; }
                    bf16_t* p = base + (size_t)row * 1024 + hcol;
                    *(u32x4*)p = pack8(r1); *(u32x4*)(p + 128) = pack8(r2); }
            return;
        }
        if (mode == 6) {
            const int ocol = u.pn * 128 + cin;
#pragma unroll
            for (int ai = 0; ai < 2; ++ai)
#pragma unroll
                for (int m = 0; m < 4; ++m) { const int row = row0 + ai * HALF + m * 16; float r[8];
#pragma unroll
                    for (int e = 0; e < 8; ++e) { const float a = acc[ai][0][m][e >> 2][e & 3], g = acc[ai][1][m][e >> 2][e & 3]; r[e] = a * sigm(a) * g; }
                    *(u32x4*)(o0 + (size_t)row * ldo + ocol) = pack8(r); }
            return;
        }
        bf16_t* ob = o0; int ocol = u.pn * BM + cin, ld = ldo; float sc = 1.f;
        if (mode == 0) { const int t = u.pn >> 2; ob = (t == 0) ? o0 : ((t == 1) ? o1 : o2); ocol = (u.pn & 3) * 256 + cin; ld = 1024; sc = (t == 0) ? 0.125f : 1.f; }
        else if (mode == 1) { ob = o2; ocol = (u.pn - 8) * 256 + cin; ld = 2048; }
#pragma unroll
        for (int ai = 0; ai < 2; ++ai)
#pragma unroll
            for (int m = 0; m < 4; ++m) { const int row = row0 + ai * HALF + m * 16;
#pragma unroll
                for (int bj = 0; bj < 2; ++bj) { const int col = ocol + bj * HALF; float r[8];
#pragma unroll
                    for (int e = 0; e < 8; ++e) r[e] = acc[ai][bj][m][e >> 2][e & 3];
                    if (mode <= 1) {
#pragma unroll
                        for (int e = 0; e < 8; ++e) r[e] *= sc;
                    } else if (mode == 2) {
#pragma unroll
                        for (int e = 0; e < 8; ++e) r[e] = sigm(r[e]);
                    } else {
                        float x[8]; unpack8(*(const u32x4*)(a1 + (size_t)row * ld1 + col), x);
                        if (mode == 3) {
#pragma unroll
                            for (int e = 0; e < 8; ++e) r[e] = r[e] * sigm(r[e]) * x[e];
                        } else if (mode == 4) {
#pragma unroll
                            for (int e = 0; e < 8; ++e) r[e] = r[e] * x[e];
                        } else {
                            float y[8]; unpack8(*(const u32x4*)(a2 + (size_t)row * ld2 + col), y);
#pragma unroll
                            for (int e = 0; e < 8; ++e) r[e] = y[e] + r[e] * x[e];
                        }
                    }
                    *(u32x4*)(ob + (size_t)row * ld + col) = pack8(r); } }
    }
};

template <class Epi, class Sched, bool ALIGN_EPI = false, bool SP2 = false>
__device__ __forceinline__ void gemm_phase(PG8_LAS unsigned char* lds, const Gemm g, const Sched& S, const Epi& E) {
    const int tid = threadIdx.x, wid = __builtin_amdgcn_readfirstlane(tid >> 6), lane = tid & 63, wr = wid >> 2, wc = wid & 3, fr = lane & 15, fq = lane >> 4;
    const int K = g.K, nt = K / BK;
    unsigned voffA[2], voffB[2];
#pragma unroll
    for (int i = 0; i < 2; ++i) { int R, C; stage_rc(tid * 16 + i * 8192, R, C); const int Rb = Epi::PERM ? ((R & ~31) + perm32(R & 31)) : R;
        voffA[i] = (unsigned)(R * K + C) * 2u; voffB[i] = (unsigned)(Rb * K + C) * 2u; }
    const size_t kstep = (size_t)(BK * 2);
    const size_t hstep = (size_t)HALF * K * 2;
    const size_t tstep = 2 * hstep;
    const unsigned ldsw = (unsigned)wid * 1024u;
    const int aoff = lds_byte(wr * 64 + fr, fq * 8), boff = lds_byte(wc * 32 + fr, fq * 8);
#define PG8_SA(b, h) (((b) * 2 + (h)) * HTB)
#define PG8_SB(b, h) ((4 + (b) * 2 + (h)) * HTB)
#define PG8_STAGE(bufoff, gbase, voff) do { _Pragma("unroll") for (int _i = 0; _i < 2; ++_i) \
        __builtin_amdgcn_global_load_lds((const unsigned*)((const char*)(gbase) + (voff)[_i]), (PG8_LAS unsigned*)(lds + (bufoff) + ldsw + _i * 8192), 16, 0, 0); } while (0)
#define PG8_LDA(dst, b, h) do { _Pragma("unroll") for (int m = 0; m < 4; ++m) _Pragma("unroll") for (int k = 0; k < 2; ++k) dst[m][k] = *(const PG8_LAS bf16x8*)(lds + PG8_SA(b, h) + aoff + m * 2048 + k * 1024); } while (0)
#define PG8_LDB(dst, b, h) do { _Pragma("unroll") for (int n = 0; n < 2; ++n) _Pragma("unroll") for (int k = 0; k < 2; ++k) dst[n][k] = *(const PG8_LAS bf16x8*)(lds + PG8_SB(b, h) + boff + n * 2048 + k * 1024); } while (0)
#define PG8_MMA(ai, bj, At, Bt) do { __builtin_amdgcn_s_setprio(1); _Pragma("unroll") for (int m = 0; m < 4; ++m) _Pragma("unroll") for (int n = 0; n < 2; ++n) _Pragma("unroll") for (int k = 0; k < 2; ++k) \
        acc[ai][bj][m][n] = __builtin_amdgcn_mfma_f32_16x16x32_bf16(Bt[n][k], At[m][k], acc[ai][bj][m][n], 0, 0, 0); __builtin_amdgcn_s_setprio(0); } while (0)
#define PG8_WAIT_V(n) asm volatile("s_waitcnt vmcnt(" #n ")" ::: "memory")
#define PG8_WAIT_L(n) asm volatile("s_waitcnt lgkmcnt(" #n ")" ::: "memory")
#define PG8_BAR __builtin_amdgcn_s_barrier()
#define PG8_SCHED __builtin_amdgcn_sched_barrier(0)
    Unit cur, nxt; int ui = 0;
    if (!S.next(0, cur)) return;
    f32x4 acc[2][2][4][2];
#pragma unroll
    for (int a = 0; a < 2; ++a)
#pragma unroll
        for (int b = 0; b < 2; ++b)
#pragma unroll
            for (int m = 0; m < 4; ++m)
#pragma unroll
                for (int n = 0; n < 2; ++n) acc[a][b][m][n] = (f32x4){0.f, 0.f, 0.f, 0.f};
    bf16x8 At[4][2], B0[2][2], B1[2][2];
    const char* cA = (const char*)g.A + (size_t)cur.pm * tstep; const char* cB = (const char*)g.Bt + (size_t)cur.pn * tstep;
    S.a_ready(cur);
    if constexpr (SP2) {
        PG8_STAGE(PG8_SB(0, 0), cB, voffB); PG8_STAGE(PG8_SB(0, 1), cB + hstep, voffB); PG8_STAGE(PG8_SA(0, 0), cA, voffA); PG8_STAGE(PG8_SA(0, 1), cA + hstep, voffA);
        if (wr == 1) PG8_BAR;
        PG8_WAIT_V(2); PG8_BAR;
        PG8_STAGE(PG8_SB(1, 0), cB + kstep, voffB); PG8_STAGE(PG8_SA(1, 0), cA + kstep, voffA); PG8_STAGE(PG8_SB(1, 1), cB + hstep + kstep, voffB);
        PG8_WAIT_V(6); PG8_BAR;
    } else {
        PG8_STAGE(PG8_SB(0, 0), cB, voffB); PG8_STAGE(PG8_SA(0, 0), cA, voffA); PG8_STAGE(PG8_SB(0, 1), cB + hstep, voffB); PG8_STAGE(PG8_SA(0, 1), cA + hstep, voffA);
        if (wr == 1) PG8_BAR;
        PG8_WAIT_V(4); PG8_BAR;
        PG8_STAGE(PG8_SB(1, 0), cB + kstep, voffB); PG8_STAGE(PG8_SA(1, 0), cA + kstep, voffA); PG8_STAGE(PG8_SB(1, 1), cB + hstep + kstep, voffB);
        PG8_WAIT_V(6); PG8_BAR;
    }
    for (;;) {
        const bool has_next = S.next(ui + 1, nxt);
        const char* nA = has_next ? (const char*)g.A + (size_t)nxt.pm * tstep : cA; const char* nB = has_next ? (const char*)g.Bt + (size_t)nxt.pn * tstep : cB;
        for (int t = 0; t < nt; t += 2) {
            const bool last = (t == nt - 2);
            const char* a1 = cA + (size_t)(t + 1) * kstep;
            const char* a2 = last ? nA : cA + (size_t)(t + 2) * kstep; const char* b2 = last ? nB : cB + (size_t)(t + 2) * kstep;
            const char* a3 = a2 + kstep; const char* b3 = b2 + kstep;
            if (last && has_next) S.a_ready(nxt);
            if constexpr (SP2) {
            PG8_LDB(B0, 0, 0); PG8_LDB(B1, 0, 1); PG8_SCHED; PG8_LDA(At, 0, 0); PG8_STAGE(PG8_SA(1, 1), a1 + hstep, voffA);
            PG8_WAIT_V(8); PG8_WAIT_L(0); PG8_BAR; PG8_MMA(0, 0, At, B0); PG8_MMA(0, 1, At, B1); PG8_BAR; PG8_SCHED;
            PG8_LDA(At, 0, 1); PG8_STAGE(PG8_SB(0, 0), b2, voffB); PG8_STAGE(PG8_SB(0, 1), b2 + hstep, voffB); PG8_STAGE(PG8_SA(0, 0), a2, voffA);
            PG8_WAIT_V(8); PG8_WAIT_L(0); PG8_BAR; PG8_MMA(1, 0, At, B0); PG8_MMA(1, 1, At, B1); PG8_BAR; PG8_SCHED;
            PG8_LDB(B0, 1, 0); PG8_LDB(B1, 1, 1); PG8_SCHED; PG8_LDA(At, 1, 0); PG8_STAGE(PG8_SA(0, 1), a2 + hstep, voffA);
            PG8_WAIT_V(8); PG8_WAIT_L(0); PG8_BAR; PG8_MMA(0, 0, At, B0); PG8_MMA(0, 1, At, B1); PG8_BAR; PG8_SCHED;
            PG8_LDA(At, 1, 1); PG8_STAGE(PG8_SB(1, 0), b3, voffB); PG8_STAGE(PG8_SB(1, 1), b3 + hstep, voffB); PG8_STAGE(PG8_SA(1, 0), a3, voffA);
            PG8_WAIT_V(8); PG8_WAIT_L(0); PG8_BAR; PG8_MMA(1, 0, At, B0); PG8_MMA(1, 1, At, B1); PG8_BAR; PG8_SCHED;
            } else {
            PG8_LDB(B0, 0, 0); PG8_SCHED; PG8_LDA(At, 0, 0); PG8_STAGE(PG8_SA(1, 1), a1 + hstep, voffA);
            PG8_WAIT_L(8); PG8_BAR; PG8_WAIT_L(0); PG8_MMA(0, 0, At, B0); PG8_BAR; PG8_SCHED;
            PG8_LDB(B1, 0, 1); PG8_STAGE(PG8_SB(0, 0), b2, voffB);
            PG8_BAR; PG8_WAIT_L(0); PG8_MMA(0, 1, At, B1); PG8_BAR;
            PG8_LDA(At, 0, 1); PG8_STAGE(PG8_SA(0, 0), a2, voffA);
            PG8_BAR; PG8_WAIT_L(0); PG8_MMA(1, 0, At, B0); PG8_BAR; PG8_SCHED;
            PG8_STAGE(PG8_SB(0, 1), b2 + hstep, voffB);
            PG8_WAIT_V(6); PG8_BAR; PG8_MMA(1, 1, At, B1); PG8_BAR;
            PG8_LDB(B0, 1, 0); PG8_SCHED; PG8_LDA(At, 1, 0); PG8_STAGE(PG8_SA(0, 1), a2 + hstep, voffA);
            PG8_WAIT_L(8); PG8_BAR; PG8_WAIT_L(0); PG8_MMA(0, 0, At, B0); PG8_BAR; PG8_SCHED;
            PG8_LDB(B1, 1, 1); PG8_STAGE(PG8_SB(1, 0), b3, voffB);
            PG8_BAR; PG8_WAIT_L(0); PG8_MMA(0, 1, At, B1); PG8_BAR;
            PG8_LDA(At, 1, 1); PG8_STAGE(PG8_SA(1, 0), a3, voffA);
            PG8_BAR; PG8_WAIT_L(0); PG8_MMA(1, 0, At, B0); PG8_BAR; PG8_SCHED;
            PG8_STAGE(PG8_SB(1, 1), b3 + hstep, voffB);
            PG8_WAIT_V(6); PG8_BAR; PG8_MMA(1, 1, At, B1); PG8_BAR;
            }
        }
        if constexpr (ALIGN_EPI) { if (wr == 0) PG8_BAR; }
        if constexpr (!Epi::AFTER_DRAIN) { E(acc, cur, wr, wc, fr, fq); S.done(cur); }
        if (!has_next) break;
#pragma unroll
        for (int a = 0; a < 2; ++a)
#pragma unroll
            for (int b = 0; b < 2; ++b)
#pragma unroll
                for (int m = 0; m < 4; ++m)
#pragma unroll
                    for (int n = 0; n < 2; ++n) acc[a][b][m][n] = (f32x4){0.f, 0.f, 0.f, 0.f};
        cur = nxt; cA = nA; cB = nB; ++ui;
        if constexpr (ALIGN_EPI) { if (wr == 1) PG8_BAR; }
    }
    PG8_WAIT_V(0);
    if constexpr (!ALIGN_EPI) { if (wr == 0) PG8_BAR; }
    PG8_BAR;
    if constexpr (Epi::AFTER_DRAIN) { E.fused(acc, cur, wr, wc, fr, fq, lds, wid, lane); S.done(cur); }
#undef PG8_SA
#undef PG8_SB
#undef PG8_STAGE
#undef PG8_LDA
#undef PG8_LDB
#undef PG8_MMA
#undef PG8_WAIT_V
#undef PG8_WAIT_L
#undef PG8_BAR
#undef PG8_SCHED
}
}
namespace cg = cooperative_groups;
#define LAS __attribute__((address_space(3)))
typedef unsigned short bf16;
typedef float f32x4 __attribute__((ext_vector_type(4)));
typedef unsigned u32x4 __attribute__((ext_vector_type(4)));
typedef unsigned u32x2 __attribute__((ext_vector_type(2)));

constexpr int NWAVES = 8, NTHREADS = 512;
constexpr int D = 1024, TP = 16384;
constexpr int FFN = 2816;
constexpr float EPS = 1e-6f;
constexpr int NSTEP = 14, NPHASE = 2 + 2 * NSTEP;
constexpr int LDS_BYTES = 147456;
#ifndef DIS_MASK
#define DIS_MASK 0
#endif
constexpr unsigned DIS = DIS_MASK;

constexpr size_t MiB = 1u << 20;
constexpr size_t WS_CTL = 0, WS_MODP = 64 * 1024, WS_MOD = 704 * 1024;
constexpr size_t WS_WIN = 1 * MiB, WS_WNA = 23 * MiB, WS_WRET = 25 * MiB, WS_WOUT = 29 * MiB, WS_WFI = 31 * MiB, WS_WFO = 42 * MiB;
constexpr size_t WS_H = 48 * MiB, WS_NQ = 80 * MiB, WS_O = 112 * MiB, WS_NK = 112 * MiB, WS_NV = 144 * MiB, WS_RV = 176 * MiB, WS_SG = 176 * MiB;
constexpr size_t WS_MERGED = 48 * MiB, WS_OUTMIX = 112 * MiB, WS_H2 = 80 * MiB, WS_ACT = 112 * MiB, WS_F = 48 * MiB, WS_END = 256 * MiB;

__device__ __forceinline__ float wave_sum(float v) {
#pragma unroll
    for (int o = 1; o < 64; o <<= 1) v += __shfl_xor(v, o);
    return v;
}
__device__ __forceinline__ float bf2f(unsigned short b) { return __uint_as_float((unsigned)b << 16); }
__device__ __forceinline__ unsigned pk2(float lo, float hi) { return pg8::cvt_pk_bf16(lo, hi); }
__device__ __forceinline__ float rdlane(float v, int l) { return __int_as_float(__builtin_amdgcn_readlane(__float_as_int(v), l)); }

__device__ __forceinline__ void transpose_item(const float* W, int K, int N, bf16* WT, int k0, int n0, int drow0, LAS float* scr, int lane) {
#pragma unroll 8
    for (int i = 0; i < 32; ++i) { const int kk = 2 * i + (lane >> 5); scr[kk * 33 + (lane & 31)] = W[(size_t)(k0 + kk) * N + n0 + (lane & 31)]; }
    asm volatile("s_waitcnt lgkmcnt(0)" ::: "memory");
    const int c = lane & 7;
#pragma unroll
    for (int j = 0; j < 4; ++j) { const int n = (lane >> 3) + 8 * j; const LAS float* s = scr + (8 * c) * 33 + n;
        u32x4 o; o.x = pk2(s[0 * 33], s[1 * 33]); o.y = pk2(s[2 * 33], s[3 * 33]); o.z = pk2(s[4 * 33], s[5 * 33]); o.w = pk2(s[6 * 33], s[7 * 33]);
        *(u32x4*)(WT + (size_t)(drow0 + n) * K + k0 + 8 * c) = o; }
    asm volatile("s_waitcnt lgkmcnt(0)" ::: "memory");
}

#define RLX_AGENT __ATOMIC_RELAXED, __HIP_MEMORY_SCOPE_AGENT
#define XB_TMO      128
#define XB_XCNT(j)  (256  + 64 * (j))
#define XB_XSUB(j)  (1280 + 64 * (j))
#define XB_XGEN(j)  (2304 + 64 * (j))
#define XB_TOP      3328
#define XB_TOPGEN   3392
#define XCD_BAR_WORDS 3456
#define XB_SPIN_CAP (1u << 18)

__device__ __forceinline__ unsigned xb_ld(unsigned* p)              { return __hip_atomic_load(p, __ATOMIC_RELAXED, __HIP_MEMORY_SCOPE_AGENT); }
__device__ __forceinline__ unsigned xb_add(unsigned* p, unsigned v) { return __hip_atomic_fetch_add(p, v, __ATOMIC_RELAXED, __HIP_MEMORY_SCOPE_AGENT); }
__device__ __forceinline__ unsigned xb_xcc_id() { return (unsigned)__builtin_amdgcn_s_getreg((3 << 11) | 20) & 0xFu; }
#define XB_SPIN(cond, bar) do { unsigned _sp = 0; while (cond) { __builtin_amdgcn_s_sleep(1); \
    if ((++_sp & 255u) == 0u) { if (xb_ld(&(bar)[XB_TMO])) break; if (_sp > XB_SPIN_CAP) { atomicAdd(&(bar)[XB_TMO], 1u); break; } } } } while (0)

struct XcdBarrier {
    unsigned* bar; unsigned x;
    volatile LAS unsigned* st;
};

__device__ __forceinline__ XcdBarrier xcd_barrier_post(unsigned* bar, volatile LAS unsigned* st) {
    XcdBarrier b; b.bar = bar; b.x = xb_xcc_id(); b.st = st;
    if (threadIdx.x == 0) (void)xb_add(&bar[XB_XCNT(b.x)], 1u);
    return b;
}
__device__ __forceinline__ void xcd_barrier_complete(unsigned* bar, unsigned x, unsigned& nloc, unsigned& nx) {
    const unsigned G = gridDim.x * gridDim.y * gridDim.z;
    unsigned sum, cnt, mine, sp = 0u;
    for (;;) {
        sum = 0u; cnt = 0u; mine = 0u;
#pragma unroll
        for (unsigned j = 0; j < 16; ++j) { const unsigned c = xb_ld(&bar[XB_XCNT(j)]); sum += c; cnt += (c > 0u) ? 1u : 0u; mine = (j == x) ? c : mine; }
        if (sum == G) break;
        __builtin_amdgcn_s_sleep(1);
        if ((++sp & 255u) == 0u) { if (xb_ld(&bar[XB_TMO])) break; if (sp > XB_SPIN_CAP) { atomicAdd(&bar[XB_TMO], 1u); break; } }
    }
    nloc = mine > 0u ? mine : 1u; nx = cnt > 0u ? cnt : 1u;
}

__device__ __forceinline__ void xcd_barrier(const XcdBarrier& b) {
    asm volatile("s_waitcnt vmcnt(0)" ::: "memory");
    __syncthreads();
    if (threadIdx.x == 0) {
        unsigned* bar = b.bar;
        __builtin_amdgcn_s_waitcnt(0);
        unsigned nloc = b.st[0], nx = b.st[1];
        if (nloc == 0u) { xcd_barrier_complete(bar, b.x, nloc, nx); b.st[0] = nloc; b.st[1] = nx; }
        const unsigned old = xb_add(&bar[XB_XSUB(b.x)], 1u);
        const unsigned gen = old / nloc;
        if (old + 1u == (gen + 1u) * nloc) {
            __builtin_amdgcn_fence(__ATOMIC_RELEASE, "agent");
            asm volatile("s_waitcnt vmcnt(0)" ::: "memory");
            const unsigned og = xb_add(&bar[XB_TOP], 1u);
            const unsigned tg = og / nx;
            if (og + 1u == (tg + 1u) * nx) xb_add(&bar[XB_TOPGEN], 1u);
            else XB_SPIN(xb_ld(&bar[XB_TOPGEN]) == tg, bar);
            __builtin_amdgcn_fence(__ATOMIC_ACQUIRE, "agent");
            xb_add(&bar[XB_XGEN(b.x)], 1u);
            asm volatile("s_waitcnt vmcnt(0)" ::: "memory");
        } else {
            XB_SPIN(xb_ld(&bar[XB_XGEN(b.x)]) == gen, bar);
            __builtin_amdgcn_fence(__ATOMIC_ACQUIRE, "agent");
            asm volatile("s_waitcnt vmcnt(0)" ::: "memory");
        }
    }
    __syncthreads();
}

constexpr int CW_BAR = 4096;
constexpr int RING_BYTES = 131072, MISC_OFF = RING_BYTES + 320;
constexpr size_t CTL_ZERO_BYTES = 64 * 1024;
#ifndef ONE_LAUNCH
#define ONE_LAUNCH 1
#endif
struct Args { const float* in[19]; float* out; unsigned char* ws; int ph_lo, ph_hi; };

__global__ void __launch_bounds__(NTHREADS, 2) fwd(Args args) {
    extern __shared__ __attribute__((aligned(16))) unsigned char lds_raw[];
    LAS unsigned char* lds = (LAS unsigned char*)lds_raw;
    for (int u = threadIdx.x; u < (LDS_BYTES - RING_BYTES) / 4; u += NTHREADS) ((LAS unsigned*)(lds + RING_BYTES))[u] = 0u;
    __syncthreads();
    if (args.ph_hi - args.ph_lo > 1) (void)xcd_barrier_post((unsigned*)(args.ws + WS_CTL) + CW_BAR, (volatile LAS unsigned*)(lds + MISC_OFF) + 8);
    for (int ph = args.ph_lo; ph < args.ph_hi; ++ph) {
    int tid = threadIdx.x; asm volatile("" : "+v"(tid));
    const int lane = tid & 63, wave = __builtin_amdgcn_readfirstlane(tid >> 6);
    const int G = gridDim.x, gw = blockIdx.x * NWAVES + wave, NGW = G * NWAVES;
    size_t zoff = 0; asm volatile("" : "+s"(zoff)); unsigned char* ws = args.ws + zoff;
    const float* x_prompt = args.in[0]; const float* x_sample = args.in[1]; const float* c_prompt = args.in[2]; const float* c_sample = args.in[3];
    const float* w_mod = args.in[4]; const float* b_mod = args.in[5]; const float* g_pre_mix = args.in[6]; const float* w_in = args.in[7];
    const float* rpb = args.in[8]; const float* decay_logit = args.in[9]; const float* ret_gn = args.in[10]; const float* w_up_na = args.in[11];
    const float* w_up_ret = args.in[12]; const float* w_out = args.in[13]; const float* g_post_mix = args.in[14]; const float* g_pre_ffn = args.in[15];
    const float* w_ffn_in = args.in[16]; const float* w_ffn_out = args.in[17]; const float* g_post_ffn = args.in[18];
    float* MODP = (float*)(ws + WS_MODP); float* MOD = (float*)(ws + WS_MOD);
    bf16* WIN = (bf16*)(ws + WS_WIN); bf16* WNA = (bf16*)(ws + WS_WNA); bf16* WRET = (bf16*)(ws + WS_WRET); bf16* WOUT = (bf16*)(ws + WS_WOUT);
    bf16* WFI = (bf16*)(ws + WS_WFI); bf16* WFO = (bf16*)(ws + WS_WFO);
    bf16* Hb = (bf16*)(ws + WS_H); bf16* NQ = (bf16*)(ws + WS_NQ); bf16* NK = (bf16*)(ws + WS_NK); bf16* NV = (bf16*)(ws + WS_NV);
    bf16* Ob = (bf16*)(ws + WS_O); bf16* RV = (bf16*)(ws + WS_RV); bf16* SG = (bf16*)(ws + WS_SG); bf16* MERGED = (bf16*)(ws + WS_MERGED);
    float* OUTMIX = (float*)(ws + WS_OUTMIX); bf16* H2 = (bf16*)(ws + WS_H2); bf16* ACT = (bf16*)(ws + WS_ACT); float* Fb = (float*)(ws + WS_F);
        if (ph == 0 && !(DIS & 1)) {
            LAS float* scr = (LAS float*)(lds + wave * 16384);
            constexpr int I_IN = 16 * 352, I_NA = 16 * 32, I_RET = 32 * 32, I_OUT = 16 * 32, I_FI = 16 * 176, I_FO = 44 * 32, I_MOD = 96 * 8;
            constexpr int NITEMS = I_IN + I_NA + I_RET + I_OUT + I_FI + I_FO + I_MOD;
            for (int it = gw; it < NITEMS; it += NGW) {
                int r = it;
                if (r < I_IN) { const int nb = r % 352, kb = r / 352; transpose_item(w_in, 1024, 11264, WIN, 64 * kb, 32 * nb, 32 * nb, scr, lane); continue; } r -= I_IN;
                if (r < I_NA) { const int nb = r % 32, kb = r / 32; transpose_item(w_up_na, 1024, 1024, WNA, 64 * kb, 32 * nb, 32 * nb, scr, lane); continue; } r -= I_NA;
                if (r < I_RET) { const int nb = r % 32, kb = r / 32; transpose_item(w_up_ret, 2048, 1024, WRET, 64 * kb, 32 * nb, 32 * nb, scr, lane); continue; } r -= I_RET;
                if (r < I_OUT) { const int nb = r % 32, kb = r / 32; transpose_item(w_out, 1024, 1024, WOUT, 64 * kb, 32 * nb, 32 * nb, scr, lane); continue; } r -= I_OUT;
                if (r < I_FI) { const int nb = r % 176, kb = r / 176; const int n0 = 32 * nb; const int j = (n0 < FFN) ? n0 : n0 - FFN;
                    const int drow = 256 * (j / 128) + (j % 128) + ((n0 < FFN) ? 0 : 128);
                    transpose_item(w_ffn_in, 1024, 2 * FFN, WFI, 64 * kb, n0, drow, scr, lane); continue; } r -= I_FI;
                if (r < I_FO) { const int nb = r % 32, kb = r / 32; transpose_item(w_ffn_out, FFN, 1024, WFO, 64 * kb, 32 * nb, 32 * nb, scr, lane); continue; } r -= I_FO;
                { const int strip = r % 96, kc = r / 96; const int j = strip * 64 + lane; float a0 = 0.f, a1 = 0.f, a2 = 0.f;
                    for (int k = kc * 128; k < kc * 128 + 128; ++k) { const float w = w_mod[(size_t)k * 6144 + j];
                        const float c0 = c_prompt[k], c1 = c_prompt[1024 + k], c2 = c_sample[k];
                        a0 += c0 * pg8::sigm(c0) * w; a1 += c1 * pg8::sigm(c1) * w; a2 += c2 * pg8::sigm(c2) * w; }
                    MODP[(kc * 3 + 0) * 6144 + j] = a0; MODP[(kc * 3 + 1) * 6144 + j] = a1; MODP[(kc * 3 + 2) * 6144 + j] = a2; }
            }
        } else if (ph == 1 && !(DIS & 2)) {
            for (int i = blockIdx.x * NTHREADS + tid; i < 3 * 6144; i += G * NTHREADS) { float s = b_mod[i % 6144];
#pragma unroll
                for (int kc = 0; kc < 8; ++kc) s += MODP[kc * 3 * 6144 + i];
                MOD[i] = s; }
        } else {
            const int pass = (ph - 2) / NSTEP, step = (ph - 2) % NSTEP;
            const float* xin = pass == 0 ? x_sample : x_prompt; float* outp = args.out + (pass == 0 ? (size_t)TP * D : 0);
            const int seqlen = pass == 0 ? 16384 : 8192, seq0 = pass == 0 ? 2 : 0, nseq = pass == 0 ? 1 : 2;
            bf16* RQ = (bf16*)outp; bf16* RK = RQ + (size_t)TP * 1024; bf16* TNA = RQ;
            if (step == 0 && !(DIS & 4)) {
                for (int t = gw; t < TP; t += NGW) { const float* mod = MOD + (size_t)(seq0 + t / seqlen) * 6144;
                    const f32x4* xr = (const f32x4*)(xin + (size_t)t * D) + lane; f32x4 v[4]; float ss = 0.f;
#pragma unroll
                    for (int j = 0; j < 4; ++j) { v[j] = xr[64 * j]; ss += (v[j].x * v[j].x + v[j].y * v[j].y) + (v[j].z * v[j].z + v[j].w * v[j].w); }
                    const float rstd = 1.0f / sqrtf(wave_sum(ss) * (1.f / D) + EPS);
                    u32x2* o8 = (u32x2*)(Hb + (size_t)t * D) + lane;
#pragma unroll
                    for (int j = 0; j < 4; ++j) { const int c = 4 * lane + 256 * j; const f32x4 g = *(const f32x4*)(g_pre_mix + c), sh = *(const f32x4*)(mod + c), sc = *(const f32x4*)(mod + 1024 + c);
                        const f32x4 h = v[j] * rstd * g * (sc + 1.0f) + sh; u32x2 w; w.x = pk2(h.x, h.y); w.y = pk2(h.z, h.w); o8[64 * j] = w; }
                }
            } else if ((step == 1 || step == 3 || step == 5 || step == 6 || step == 7 || step == 8 || step == 11) && !(DIS & 8)) {
                if (step == 5) {
                    for (int t = gw; t < TP; t += NGW) {
#pragma unroll
                        for (int h = 0; h < 4; ++h) { bf16* p = Ob + (size_t)t * 2048 + 512 * h + 8 * lane; float f[8]; pg8::unpack8(*(const u32x4*)p, f);
                            float s = 0.f;
#pragma unroll
                            for (int e = 0; e < 8; ++e) s += f[e];
                            const float mu = wave_sum(s) * (1.f / 512.f); float q = 0.f;
#pragma unroll
                            for (int e = 0; e < 8; ++e) { f[e] -= mu; q += f[e] * f[e]; }
                            const float rstd = 1.0f / sqrtf(wave_sum(q) * (1.f / 512.f) + EPS);
                            const f32x4 g0 = *(const f32x4*)(ret_gn + 512 * h + 8 * lane), g1 = *(const f32x4*)(ret_gn + 512 * h + 8 * lane + 4);
                            f[0] *= rstd * g0.x; f[1] *= rstd * g0.y; f[2] *= rstd * g0.z; f[3] *= rstd * g0.w; f[4] *= rstd * g1.x; f[5] *= rstd * g1.y; f[6] *= rstd * g1.z; f[7] *= rstd * g1.w;
                            *(u32x4*)p = pg8::pack8(f); }
                    }
                    __syncthreads();
                }
                pg8::Gemm g; pg8::EpiBf E; E.o1 = nullptr; E.o2 = nullptr; E.a1 = nullptr; E.a2 = nullptr; E.ldo = 1024; E.ld1 = 2048; E.ld2 = 1024; E.seqmask = seqlen - 1;
                if (step == 1)       { g = pg8::Gemm{Hb, WIN, TP, 3072, 1024}; E.mode = 0; E.o0 = NQ; E.o1 = NK; E.o2 = NV; }
                else if (step == 3)  { g = pg8::Gemm{Hb, WIN + (size_t)3072 * 1024, TP, 4096, 1024}; E.mode = 1; E.o0 = RQ; E.o1 = RK; E.o2 = RV; }
                else if (step == 5)  { g = pg8::Gemm{Hb, WIN + (size_t)9216 * 1024, TP, 2048, 1024}; E.mode = 2; E.o0 = SG; E.ldo = 2048; }
                else if (step == 6)  { g = pg8::Gemm{Hb, WIN + (size_t)7168 * 1024, TP, 2048, 1024}; E.mode = 3; E.o0 = Ob; E.ldo = 2048; E.a1 = Ob; E.ld1 = 2048; }
                else if (step == 7)  { g = pg8::Gemm{NQ, WNA, TP, 1024, 1024}; E.mode = 4; E.o0 = TNA; E.ldo = 1024; E.a1 = SG; E.ld1 = 2048; }
                else if (step == 8)  { g = pg8::Gemm{Ob, WRET, TP, 1024, 2048}; E.mode = 5; E.o0 = MERGED; E.ldo = 1024; E.a1 = SG + 1024; E.ld1 = 2048; E.a2 = TNA; E.ld2 = 1024; }
                else                 { g = pg8::Gemm{H2, WFI, TP, 2 * FFN, 1024}; E.mode = 6; E.o0 = ACT; E.ldo = FFN; }
                pg8::StaticOrder S; S.init(g.M, g.N, G, (int)blockIdx.x);
                pg8::gemm_phase<pg8::EpiBf, pg8::StaticOrder, true, true>(lds, g, S, E);
            } else if ((step == 9 || step == 12) && !(DIS & 16)) {
                pg8::Gemm g; pg8::EpiF32 E;
                if (step == 9) { g = pg8::Gemm{MERGED, WOUT, TP, 1024, 1024}; E.C = OUTMIX; E.ldc = 1024; }
                else           { g = pg8::Gemm{ACT, WFO, TP, 1024, FFN}; E.C = Fb; E.ldc = 1024; }
                pg8::StaticOrder S; S.init(g.M, g.N, G, (int)blockIdx.x);
                pg8::gemm_phase<pg8::EpiF32, pg8::StaticOrder, true, true>(lds, g, S, E);
            } else if (step == 2 && !(DIS & 32)) {
                const int rows = seqlen / 64;
                for (int un = blockIdx.x; un < 512; un += G) { const int R = un >> 1, h = (un & 1) * 8 + wave, c = lane, t = R * 64 + c;
                    const int r = R % rows, Rb = R - r; int rs = r - 4; rs = rs < 0 ? 0 : rs; rs = rs > rows - 8 ? rows - 8 : rs; int cs = c - 8; cs = cs < 0 ? 0 : cs; cs = cs > 48 ? 48 : cs;
                    float q[64], acc[64];
#pragma unroll
                    for (int i = 0; i < 8; ++i) { float f[8]; pg8::unpack8(*(const u32x4*)(NQ + (size_t)t * 1024 + 64 * h + 8 * i), f);
#pragma unroll
                        for (int e = 0; e < 8; ++e) { q[8 * i + e] = f[e]; acc[8 * i + e] = 0.f; } }
                    float mx = -INFINITY, l = 0.f;
                    for (int kr = 0; kr < 8; ++kr) for (int kc = 0; kc < 16; ++kc) { const int tk = (Rb + rs + kr) * 64 + cs + kc;
                        float s = rpb[(h * 15 + (rs + kr - r + 7)) * 31 + (cs + kc - c + 15)];
#pragma unroll
                        for (int i = 0; i < 8; ++i) { float f[8]; pg8::unpack8(*(const u32x4*)(NK + (size_t)tk * 1024 + 64 * h + 8 * i), f);
#pragma unroll
                            for (int e = 0; e < 8; ++e) s += q[8 * i + e] * f[e]; }
                        const float mn = fmaxf(mx, s), fo = __expf(mx - mn), p = __expf(s - mn); l = l * fo + p; mx = mn;
#pragma unroll
                        for (int i = 0; i < 8; ++i) { float f[8]; pg8::unpack8(*(const u32x4*)(NV + (size_t)tk * 1024 + 64 * h + 8 * i), f);
#pragma unroll
                            for (int e = 0; e < 8; ++e) acc[8 * i + e] = acc[8 * i + e] * fo + p * f[e]; } }
                    const float il = 1.0f / l;
#pragma unroll
                    for (int i = 0; i < 8; ++i) { float f[8];
#pragma unroll
                        for (int e = 0; e < 8; ++e) f[e] = acc[8 * i + e] * il;
                        *(u32x4*)(NQ + (size_t)t * 1024 + 64 * h + 8 * i) = pg8::pack8(f); }
                }
            } else if (step == 4 && !(DIS & 64)) {
                LAS float* red = (LAS float*)lds;
                for (int item = blockIdx.x; item < nseq * 32; item += G) { const int sq = item / 32, h = (item >> 3) & 3, sl = item & 7; const size_t tb = (size_t)sq * seqlen;
                    const int qoff = 256 * h + 32 * wave + (lane & 31), voff = 512 * h + 64 * sl + lane;
                    for (int dir = 0; dir < 2; ++dir) { const float lg = decay_logit[dir * 4 + h]; const float gam = 1.0f / (1.0f + expf(-lg));
                        float S[32];
#pragma unroll
                        for (int d = 0; d < 32; ++d) S[d] = 0.f;
                        for (int i = 0; i < seqlen; ++i) { const int n = dir == 0 ? i : seqlen - 1 - i; const size_t t = tb + n;
                            const float qv = bf2f(RQ[t * 1024 + qoff]), kv = bf2f(RK[t * 1024 + qoff]), v = bf2f(RV[t * 2048 + voff]); float part = 0.f;
                            if (dir == 0) {
#pragma unroll
                                for (int d = 0; d < 32; ++d) { S[d] = gam * S[d] + rdlane(kv, d) * v; part += rdlane(qv, d) * S[d]; }
                            } else {
#pragma unroll
                                for (int d = 0; d < 32; ++d) { part += rdlane(qv, d) * S[d]; S[d] = gam * (S[d] + rdlane(kv, d) * v); }
                            }
                            red[((i & 1) * 8 + wave) * 64 + lane] = part;
                            __syncthreads();
                            if (wave == 0) { float s = 0.f;
#pragma unroll
                                for (int w = 0; w < 8; ++w) s += red[((i & 1) * 8 + w) * 64 + lane];
                                bf16* op = Ob + t * 2048 + voff; if (dir == 1) s += bf2f(*op);
                                *op = (bf16)(pk2(s, 0.f) & 0xffffu); }
                        }
                        __syncthreads();
                    }
                }
            } else if (step == 10 && !(DIS & 128)) {
                for (int t = gw; t < TP; t += NGW) { const float* mod = MOD + (size_t)(seq0 + t / seqlen) * 6144;
                    const f32x4* orow = (const f32x4*)(OUTMIX + (size_t)t * D) + lane; const f32x4* xr = (const f32x4*)(xin + (size_t)t * D) + lane; f32x4 v[4]; float ss = 0.f;
#pragma unroll
                    for (int j = 0; j < 4; ++j) { v[j] = orow[64 * j]; ss += (v[j].x * v[j].x + v[j].y * v[j].y) + (v[j].z * v[j].z + v[j].w * v[j].w); }
                    const float rstd = 1.0f / sqrtf(wave_sum(ss) * (1.f / D) + EPS); float s2 = 0.f;
                    f32x4* o4 = (f32x4*)(outp + (size_t)t * D) + lane;
#pragma unroll
                    for (int j = 0; j < 4; ++j) { const int c = 4 * lane + 256 * j; const f32x4 g = *(const f32x4*)(g_post_mix + c), gt = *(const f32x4*)(mod + 2048 + c);
                        v[j] = xr[64 * j] + gt * (v[j] * rstd * g); o4[64 * j] = v[j]; s2 += (v[j].x * v[j].x + v[j].y * v[j].y) + (v[j].z * v[j].z + v[j].w * v[j].w); }
                    const float rstd2 = 1.0f / sqrtf(wave_sum(s2) * (1.f / D) + EPS);
                    u32x2* o8 = (u32x2*)(H2 + (size_t)t * D) + lane;
#pragma unroll
                    for (int j = 0; j < 4; ++j) { const int c = 4 * lane + 256 * j; const f32x4 g = *(const f32x4*)(g_pre_ffn + c), sh = *(const f32x4*)(mod + 3072 + c), sc = *(const f32x4*)(mod + 4096 + c);
                        const f32x4 h = v[j] * rstd2 * g * (sc + 1.0f) + sh; u32x2 w; w.x = pk2(h.x, h.y); w.y = pk2(h.z, h.w); o8[64 * j] = w; }
                }
            } else if (step == 13 && !(DIS & 256)) {
                for (int t = gw; t < TP; t += NGW) { const float* mod = MOD + (size_t)(seq0 + t / seqlen) * 6144;
                    const f32x4* frow = (const f32x4*)(Fb + (size_t)t * D) + lane; f32x4* o4 = (f32x4*)(outp + (size_t)t * D) + lane; f32x4 v[4]; float ss = 0.f;
#pragma unroll
                    for (int j = 0; j < 4; ++j) { v[j] = frow[64 * j]; ss += (v[j].x * v[j].x + v[j].y * v[j].y) + (v[j].z * v[j].z + v[j].w * v[j].w); }
                    const float rstd = 1.0f / sqrtf(wave_sum(ss) * (1.f / D) + EPS);
#pragma unroll
                    for (int j = 0; j < 4; ++j) { const int c = 4 * lane + 256 * j; const f32x4 g = *(const f32x4*)(g_post_ffn + c), gt = *(const f32x4*)(mod + 5120 + c);
                        o4[64 * j] = o4[64 * j] + gt * (v[j] * rstd * g); }
                }
            }
        }
        if (ph + 1 < args.ph_hi) {
            if (ph == 0) cg::this_grid().sync();
            else { XcdBarrier bar; bar.bar = (unsigned*)(args.ws + WS_CTL) + CW_BAR; bar.x = xb_xcc_id(); bar.st = (volatile LAS unsigned*)(lds + MISC_OFF) + 8; xcd_barrier(bar); }
        }
    }
}

extern "C" void kernel_launch(void* const* d_in, const int* in_sizes, int n_in, void* d_out, int out_size, void* d_ws, size_t ws_size, hipStream_t stream) {
    static int grid = 0;
    if (grid == 0) {
        if (n_in != 19 || out_size != 2 * TP * D || ws_size < WS_END) { fprintf(stderr, "kernel_launch: unexpected shapes (n_in %d out %d ws %zu)\n", n_in, out_size, ws_size); grid = -1; return; }
        int dev = 0, cus = 0;
        if (hipGetDevice(&dev) != hipSuccess || hipDeviceGetAttribute(&cus, hipDeviceAttributeMultiprocessorCount, dev) != hipSuccess) { grid = -1; return; }
        if (hipFuncSetAttribute((const void*)fwd, hipFuncAttributeMaxDynamicSharedMemorySize, LDS_BYTES) != hipSuccess) { fprintf(stderr, "kernel_launch: hipFuncSetAttribute failed\n"); grid = -1; return; }
        grid = cus;
    }
    if (grid < 0) return;
    Args a{};
    for (int i = 0; i < 19; ++i) a.in[i] = (const float*)d_in[i];
    a.out = (float*)d_out; a.ws = (unsigned char*)d_ws;
#if ONE_LAUNCH
    if (hipMemsetAsync((char*)d_ws + WS_CTL, 0, CTL_ZERO_BYTES, stream) != hipSuccess) { fprintf(stderr, "kernel_launch: memset failed\n"); return; }
    a.ph_lo = 0; a.ph_hi = NPHASE;
    void* kargs[] = {&a};
    const hipError_t e = hipLaunchCooperativeKernel((const void*)fwd, dim3(grid), dim3(NTHREADS), kargs, LDS_BYTES, stream);
    if (e != hipSuccess) fprintf(stderr, "kernel_launch: cooperative launch failed: %s (grid %d)\n", hipGetErrorString(e), grid);
#else
    for (int ph = 0; ph < NPHASE; ++ph) { a.ph_lo = ph; a.ph_hi = ph + 1; hipLaunchKernelGGL(fwd, dim3(grid), dim3(NTHREADS), LDS_BYTES, stream, a); }
#endif
}
```

```cpp
#include <hip/hip_runtime.h>
#include <hip/hip_cooperative_groups.h>
#include <cstdio>
#include <cstdint>
__device__ const float INVT[128] = {1.591549367e-01f, 1.481051445e-01f, 1.378225088e-01f, 1.282537729e-01f, 1.193493679e-01f, 1.110631898e-01f, 1.033522934e-01f, 9.617675841e-02f, 8.949939907e-02f, 8.328563720e-02f, 7.750328630e-02f, 7.212239504e-02f, 6.711508334e-02f, 6.245541945e-02f, 5.811926723e-02f, 5.408416688e-02f, 5.032921210e-02f, 4.683495685e-02f, 4.358330369e-02f, 4.055740312e-02f, 3.774158657e-02f, 3.512126207e-02f, 3.268286586e-02f, 3.041376173e-02f, 2.830219641e-02f, 2.633723244e-02f, 2.450869232e-02f, 2.280710265e-02f, 2.122365311e-02f, 1.975013874e-02f, 1.837892644e-02f, 1.710291393e-02f, 1.591549441e-02f, 1.481051371e-02f, 1.378225069e-02f, 1.282537635e-02f, 1.193493698e-02f, 1.110631879e-02f, 1.033522934e-02f, 9.617676027e-03f, 8.949940093e-03f, 8.328564465e-03f, 7.750329096e-03f, 7.212239318e-03f, 6.711508147e-03f, 6.245541852e-03f, 5.811926909e-03f, 5.408416502e-03f, 5.032921210e-03f, 4.683495965e-03f, 4.358330276e-03f, 4.055740312e-03f, 3.774158424e-03f, 3.512126394e-03f, 3.268286586e-03f, 3.041376127e-03f, 2.830219688e-03f, 2.633723198e-03f, 2.450869186e-03f, 2.280710265e-03f, 2.122365171e-03f, 1.975013874e-03f, 1.837892574e-03f, 1.710291486e-03f, 1.591549488e-03f, 1.481051440e-03f, 1.378225046e-03f, 1.282537705e-03f, 1.193493721e-03f, 1.110631856e-03f, 1.033523004e-03f, 9.617675678e-04f, 8.949940093e-04f, 8.328563999e-04f, 7.750329096e-04f, 7.212239434e-04f, 6.711508031e-04f, 6.245541736e-04f, 5.811926676e-04f, 5.408416619e-04f, 5.032921326e-04f, 4.683495790e-04f, 4.358330334e-04f, 4.055740137e-04f, 3.774158540e-04f, 3.512126277e-04f, 3.268286528e-04f, 3.041376185e-04f, 2.830219455e-04f, 2.633723198e-04f, 2.450869069e-04f, 2.280710323e-04f, 2.122365258e-04f, 1.975013729e-04f, 1.837892632e-04f, 1.710291544e-04f, 1.591549371e-04f, 1.481051440e-04f, 1.378224988e-04f, 1.282537705e-04f, 1.193493736e-04f, 1.110631856e-04f, 1.033522931e-04f, 9.617675823e-05f, 8.949940093e-05f, 8.328563854e-05f, 7.750328950e-05f, 7.212239143e-05f, 6.711508468e-05f, 6.245542318e-05f, 5.811926894e-05f, 5.408416473e-05f, 5.032921035e-05f, 4.683495717e-05f, 4.358330261e-05f, 4.055740283e-05f, 3.774158540e-05f, 3.512126204e-05f, 3.268286673e-05f, 3.041376112e-05f, 2.830219637e-05f, 2.633723125e-05f, 2.450869215e-05f, 2.280710396e-05f, 2.122365186e-05f, 1.975013765e-05f, 1.837892523e-05f, 1.710291508e-05f};
namespace pg8 {
#define PG8_LAS __attribute__((address_space(3)))
typedef unsigned short bf16_t;
typedef short bf16x8 __attribute__((ext_vector_type(8)));
typedef float f32x4 __attribute__((ext_vector_type(4)));
typedef unsigned u32x4 __attribute__((ext_vector_type(4)));
constexpr int BM = 256, BK = 64, HALF = 128, HTB = HALF * BK * 2  , STAGE_BYTES = 8 * HTB, NXCD = 8, WGM = 8;

__host__ __device__ __forceinline__ int lds_byte(int r, int c) { const int st = (r >> 4) * 2 + (c >> 5), rr = r & 15, cc = c & 31, ob = rr * 64 + cc * 2; return st * 1024 + (ob ^ (((ob >> 9) & 1) << 5)); }
__host__ __device__ __forceinline__ void stage_rc(int b, int& R, int& C) { const int st = b / 1024, sb = b % 1024, swz = sb ^ (((sb >> 9) & 1) << 5); R = (st >> 1) * 16 + swz / 64; C = (st & 1) * 32 + (swz % 64) / 2; }
__host__ __device__ __forceinline__ int perm32(int rho) { const int n = rho >> 4, i = rho & 15; return 8 * (i >> 2) + 4 * n + (i & 3); }

struct Unit { int pm, pn; };
struct Gemm { const bf16_t* A; const bf16_t* Bt; int M, N, K; };

struct StaticOrder {
    int nM, nN, nwg, G, c;
    __host__ __device__ void init(int M, int N, int G_, int c_) { nM = M / BM; nN = N / BM; nwg = nM * nN; G = G_; c = c_; }
    __host__ __device__ bool next(int i, Unit& u) const {
        const long L = (long)i * G + c; if (L >= nwg) return false;
        int wgid = (int)L; { const int q = nwg / NXCD, r = nwg % NXCD, xcd = wgid % NXCD, off = wgid / NXCD; wgid = (xcd < r ? xcd * (q + 1) : r * (q + 1) + (xcd - r) * q) + off; }
        const int nig = WGM * nN, gid = wgid / nig, fm = gid * WGM, gsz = (nM - fm) < WGM ? (nM - fm) : WGM;
        u.pm = fm + ((wgid % nig) % gsz); u.pn = (wgid % nig) / gsz; return true;
    }
    __device__ __forceinline__ void a_ready(const Unit&) const {}
    __device__ __forceinline__ void done(const Unit&) const {}
};
typedef float f32x2_cv __attribute__((ext_vector_type(2))); typedef __bf16 bf16x2_cv __attribute__((ext_vector_type(2)));
__device__ __forceinline__ unsigned cvt_pk_bf16(float lo, float hi) { const f32x2_cv v = {lo, hi}; return __builtin_bit_cast(unsigned, __builtin_convertvector(v, bf16x2_cv)); }
__device__ __forceinline__ float bflo(unsigned w) { return __uint_as_float(w << 16); }
__device__ __forceinline__ float bfhi(unsigned w) { return __uint_as_float(w & 0xffff0000u); }
__device__ __forceinline__ float sigm(float x) { return __builtin_amdgcn_rcpf(1.f + __expf(-x)); }
__device__ __forceinline__ void unpack8(const u32x4 w, float (&f)[8]) {
    f[0] = bflo(w.x); f[1] = bfhi(w.x); f[2] = bflo(w.y); f[3] = bfhi(w.y); f[4] = bflo(w.z); f[5] = bfhi(w.z); f[6] = bflo(w.w); f[7] = bfhi(w.w); }
__device__ __forceinline__ u32x4 pack8(const float (&f)[8]) {
    u32x4 w; w.x = cvt_pk_bf16(f[0], f[1]); w.y = cvt_pk_bf16(f[2], f[3]); w.z = cvt_pk_bf16(f[4], f[5]); w.w = cvt_pk_bf16(f[6], f[7]); return w; }

struct EpiF32 {
    static constexpr bool PERM = false, AFTER_DRAIN = false;
    float* C; int ldc;
    __device__ __forceinline__ void operator()(const f32x4 (&acc)[2][2][4][2], const Unit& u, int wr, int wc, int fr, int fq) const {
        asm volatile("" : "+v"(fr), "+v"(fq));
        const int row0 = u.pm * BM + wr * 64 + fr, col0 = u.pn * BM + wc * 32 + 4 * fq;
#pragma unroll
        for (int ai = 0; ai < 2; ++ai)
#pragma unroll
            for (int m = 0; m < 4; ++m) { float* rowp = C + (size_t)(row0 + ai * HALF + m * 16) * ldc + col0;
#pragma unroll
                for (int bj = 0; bj < 2; ++bj)
#pragma unroll
                    for (int n = 0; n < 2; ++n) *(f32x4*)(rowp + bj * HALF + n * 16) = acc[ai][bj][m][n]; }
    }
};

struct EpiBf {
    static constexpr bool PERM = true, AFTER_DRAIN = false;
    int mode; bf16_t *o0, *o1, *o2; const bf16_t *a1, *a2; int ldo, ld1, ld2, seqmask;
    __device__ __forceinline__ void operator()(const f32x4 (&acc)[2][2][4][2], const Unit& u, int wr, int wc, int fr, int fq) const {
        asm volatile("" : "+v"(fr), "+v"(fq));
        const int row0 = u.pm * BM + wr * 64 + fr, cin = wc * 32 + 8 * fq;
        if (mode == 1) {
            bf16_t* base = (u.pn < 4) ? o0 : o1; const float sc = (u.pn < 4) ? 1.f : 0.0625f; const int h = u.pn & 3;
            float it[8];
#pragma unroll
            for (int e = 0; e < 8; ++e) it[e] = INVT[cin + e];
            const int s1 = cin >> 4, hb = (cin >> 3) & 1;
#pragma unroll
            for (int ai = 0; ai < 2; ++ai)
#pragma unroll
                for (int m = 0; m < 4; ++m) { const int row = row0 + ai * HALF + m * 16; const float pos = (float)(row & seqmask);
                    float r1[8], r2[8];
#pragma unroll
                    for (int e = 0; e < 8; ++e) { const float x1 = acc[ai][0][m][e >> 2][e & 3], x2 = acc[ai][1][m][e >> 2][e & 3];
                        const float f = __builtin_amdgcn_fractf(pos * it[e]); const float s = __builtin_amdgcn_sinf(f), c = __builtin_amdgcn_cosf(f);
                        r1[e] = (x1 * c - x2 * s) * sc; r2[e] = (x1 * s + x2 * c) * sc; }
                    bf16_t* p = base + ((((size_t)(h * 512 + (row >> 5)) * 16 + s1) * 64 + hb * 32 + (row & 31)) << 3);
                    *(u32x4*)p = pack8(r1); *(u32x4*)(p + 8 * 64 * 8) = pack8(r2); }
            return;
        }
        if (mode == 7) {
            const int t0 = u.pn * BM + cin;
            if (u.pm < 4) { const int h = u.pm;
#pragma unroll
                for (int m = 0; m < 4; ++m) { const int i = wr * 64 + m * 16 + fr; const float itv = INVT[i];
#pragma unroll
                    for (int bj = 0; bj < 2; ++bj) { const int t = t0 + bj * HALF; float r1[8], r2[8];
#pragma unroll
                        for (int e = 0; e < 8; ++e) { const float x1 = acc[0][bj][m][e >> 2][e & 3], x2 = acc[1][bj][m][e >> 2][e & 3]; const float pos = (float)((t + e) & seqmask);
                            const float f = __builtin_amdgcn_fractf(pos * itv); const float s = __builtin_amdgcn_sinf(f), c = __builtin_amdgcn_cosf(f);
                            r1[e] = (x1 * c - x2 * s) * 0.0625f; r2[e] = (x1 * s + x2 * c) * 0.0625f; }
                        bf16_t* p = o0 + ((((((size_t)(h * 128 + (t >> 7)) * 8 + (i >> 5)) * 8 + ((t & 127) >> 4)) * 64) + ((t >> 3) & 1) * 32 + (i & 31)) << 3);
                        *(u32x4*)p = pack8(r1); *(u32x4*)(p + 4 * 8 * 64 * 8) = pack8(r2); } }
            } else {
#pragma unroll
                for (int ai = 0; ai < 2; ++ai)
#pragma unroll
                    for (int m = 0; m < 4; ++m) { const int dvg = (u.pm - 4) * 256 + ai * HALF + wr * 64 + m * 16 + fr, h = dvg >> 9, dv = dvg & 511;
#pragma unroll
                        for (int bj = 0; bj < 2; ++bj) { const int t = t0 + bj * HALF; float r[8];
#pragma unroll
                            for (int e = 0; e < 8; ++e) r[e] = acc[ai][bj][m][e >> 2][e & 3];
                            bf16_t* p = o1 + ((((((size_t)(h * 128 + (t >> 7)) * 16 + (dv >> 5)) * 8 + ((t & 127) >> 4)) * 64) + ((t >> 3) & 1) * 32 + (dv & 31)) << 3);
                            *(u32x4*)p = pack8(r); } }
            }
            return;
        }
        if (mode == 6) {
            const int ocol = u.pn * 128 + cin;
#pragma unroll
            for (int ai = 0; ai < 2; ++ai)
#pragma unroll
                for (int m = 0; m < 4; ++m) { const int row = row0 + ai * HALF + m * 16; float r[8];
#pragma unroll
                    for (int e = 0; e < 8; ++e) { const float a = acc[ai][0][m][e >> 2][e & 3], g = acc[ai][1][m][e >> 2][e & 3]; r[e] = a * sigm(a) * g; }
                    *(u32x4*)(o0 + (size_t)row * ldo + ocol) = pack8(r); }
            return;
        }
        bf16_t* ob = o0; int ocol = u.pn * BM + cin, ld = ldo; float sc = 1.f;
        if (mode == 0) { const int t = u.pn >> 2; ob = (t == 0) ? o0 : o1 + (size_t)(t - 1) * ((size_t)16384 * 1024); ocol = (u.pn & 3) * 256 + cin; ld = 1024; sc = (t == 0) ? 0.125f : 1.f; }
#pragma unroll
        for (int ai = 0; ai < 2; ++ai)
#pragma unroll
            for (int m = 0; m < 4; ++m) { const int row = row0 + ai * HALF + m * 16;
#pragma unroll
                for (int bj = 0; bj < 2; ++bj) { const int col = ocol + bj * HALF; float r[8];
#pragma unroll
                    for (int e = 0; e < 8; ++e) r[e] = acc[ai][bj][m][e >> 2][e & 3];
                    if (mode == 0) {
#pragma unroll
                        for (int e = 0; e < 8; ++e) r[e] *= sc;
                    } else if (mode == 2) {
#pragma unroll
                        for (int e = 0; e < 8; ++e) r[e] = sigm(r[e]);
                    } else {
                        float x[8]; unpack8(*(const u32x4*)(a1 + (size_t)row * ld1 + col), x);
                        if (mode == 3) {
#pragma unroll
                            for (int e = 0; e < 8; ++e) r[e] = r[e] * sigm(r[e]) * x[e];
                        } else if (mode == 4) {
#pragma unroll
                            for (int e = 0; e < 8; ++e) r[e] = r[e] * x[e];
                        } else {
                            float y[8]; unpack8(*(const u32x4*)(a2 + (size_t)row * ld2 + col), y);
#pragma unroll
                            for (int e = 0; e < 8; ++e) r[e] = y[e] + r[e] * x[e];
                        }
                    }
                    *(u32x4*)(ob + (size_t)row * ld + col) = pack8(r); } }
    }
};

template <class Epi, class Sched, bool ALIGN_EPI = false, bool SP2 = false>
__device__ __forceinline__ void gemm_phase(PG8_LAS unsigned char* lds, const Gemm g, const Sched& S, const Epi& E) {
    int tid = threadIdx.x; asm volatile("" : "+v"(tid));
    const int wid = __builtin_amdgcn_readfirstlane(tid >> 6), lane = tid & 63, wr = wid >> 2, wc = wid & 3, fr = lane & 15, fq = lane >> 4;
    const int K = g.K, nt = K / BK;
    unsigned voffA[2], voffB[2];
#pragma unroll
    for (int i = 0; i < 2; ++i) { int R, C; stage_rc(tid * 16 + i * 8192, R, C); const int Rb = Epi::PERM ? ((R & ~31) + perm32(R & 31)) : R;
        voffA[i] = (unsigned)(R * K + C) * 2u; voffB[i] = (unsigned)(Rb * K + C) * 2u; }
    const size_t kstep = (size_t)(BK * 2);
    const size_t hstep = (size_t)HALF * K * 2;
    const size_t tstep = 2 * hstep;
    const unsigned ldsw = (unsigned)wid * 1024u;
    const int aoff = lds_byte(wr * 64 + fr, fq * 8), boff = lds_byte(wc * 32 + fr, fq * 8);
#define PG8_SA(b, h) (((b) * 2 + (h)) * HTB)
#define PG8_SB(b, h) ((4 + (b) * 2 + (h)) * HTB)
#define PG8_STAGE(bufoff, gbase, voff) do { _Pragma("unroll") for (int _i = 0; _i < 2; ++_i) \
        __builtin_amdgcn_global_load_lds((const unsigned*)((const char*)(gbase) + (voff)[_i]), (PG8_LAS unsigned*)(lds + (bufoff) + ldsw + _i * 8192), 16, 0, 0); } while (0)
#define PG8_LDA(dst, b, h) do { _Pragma("unroll") for (int m = 0; m < 4; ++m) _Pragma("unroll") for (int k = 0; k < 2; ++k) dst[m][k] = *(const PG8_LAS bf16x8*)(lds + PG8_SA(b, h) + aoff + m * 2048 + k * 1024); } while (0)
#define PG8_LDB(dst, b, h) do { _Pragma("unroll") for (int n = 0; n < 2; ++n) _Pragma("unroll") for (int k = 0; k < 2; ++k) dst[n][k] = *(const PG8_LAS bf16x8*)(lds + PG8_SB(b, h) + boff + n * 2048 + k * 1024); } while (0)
#define PG8_MMA(ai, bj, At, Bt) do { __builtin_amdgcn_s_setprio(1); _Pragma("unroll") for (int m = 0; m < 4; ++m) _Pragma("unroll") for (int n = 0; n < 2; ++n) _Pragma("unroll") for (int k = 0; k < 2; ++k) \
        acc[ai][bj][m][n] = __builtin_amdgcn_mfma_f32_16x16x32_bf16(Bt[n][k], At[m][k], acc[ai][bj][m][n], 0, 0, 0); __builtin_amdgcn_s_setprio(0); } while (0)
#define PG8_WAIT_V(n) asm volatile("s_waitcnt vmcnt(" #n ")" ::: "memory")
#define PG8_WAIT_L(n) asm volatile("s_waitcnt lgkmcnt(" #n ")" ::: "memory")
#define PG8_BAR __builtin_amdgcn_s_barrier()
#define PG8_SCHED __builtin_amdgcn_sched_barrier(0)
    Unit cur, nxt; int ui = 0;
    if (!S.next(0, cur)) return;
    f32x4 acc[2][2][4][2];
#pragma unroll
    for (int a = 0; a < 2; ++a)
#pragma unroll
        for (int b = 0; b < 2; ++b)
#pragma unroll
            for (int m = 0; m < 4; ++m)
#pragma unroll
                for (int n = 0; n < 2; ++n) acc[a][b][m][n] = (f32x4){0.f, 0.f, 0.f, 0.f};
    bf16x8 At[4][2], B0[2][2], B1[2][2];
    const char* cA = (const char*)g.A + (size_t)cur.pm * tstep; const char* cB = (const char*)g.Bt + (size_t)cur.pn * tstep;
    S.a_ready(cur);
    if constexpr (SP2) {
        PG8_STAGE(PG8_SB(0, 0), cB, voffB); PG8_STAGE(PG8_SB(0, 1), cB + hstep, voffB); PG8_STAGE(PG8_SA(0, 0), cA, voffA); PG8_STAGE(PG8_SA(0, 1), cA + hstep, voffA);
        if (wr == 1) PG8_BAR;
        PG8_WAIT_V(2); PG8_BAR;
        PG8_STAGE(PG8_SB(1, 0), cB + kstep, voffB); PG8_STAGE(PG8_SA(1, 0), cA + kstep, voffA); PG8_STAGE(PG8_SB(1, 1), cB + hstep + kstep, voffB);
        PG8_WAIT_V(6); PG8_BAR;
    } else {
        PG8_STAGE(PG8_SB(0, 0), cB, voffB); PG8_STAGE(PG8_SA(0, 0), cA, voffA); PG8_STAGE(PG8_SB(0, 1), cB + hstep, voffB); PG8_STAGE(PG8_SA(0, 1), cA + hstep, voffA);
        if (wr == 1) PG8_BAR;
        PG8_WAIT_V(4); PG8_BAR;
        PG8_STAGE(PG8_SB(1, 0), cB + kstep, voffB); PG8_STAGE(PG8_SA(1, 0), cA + kstep, voffA); PG8_STAGE(PG8_SB(1, 1), cB + hstep + kstep, voffB);
        PG8_WAIT_V(6); PG8_BAR;
    }
    for (;;) {
        const bool has_next = S.next(ui + 1, nxt);
        const char* nA = has_next ? (const char*)g.A + (size_t)nxt.pm * tstep : cA; const char* nB = has_next ? (const char*)g.Bt + (size_t)nxt.pn * tstep : cB;
        for (int t = 0; t < nt; t += 2) {
            const bool last = (t == nt - 2);
            const char* a1 = cA + (size_t)(t + 1) * kstep;
            const char* a2 = last ? nA : cA + (size_t)(t + 2) * kstep; const char* b2 = last ? nB : cB + (size_t)(t + 2) * kstep;
            const char* a3 = a2 + kstep; const char* b3 = b2 + kstep;
            if (last && has_next) S.a_ready(nxt);
            if constexpr (SP2) {
            PG8_LDB(B0, 0, 0); PG8_LDB(B1, 0, 1); PG8_SCHED; PG8_LDA(At, 0, 0); PG8_STAGE(PG8_SA(1, 1), a1 + hstep, voffA);
            PG8_WAIT_V(8); PG8_WAIT_L(0); PG8_BAR; PG8_MMA(0, 0, At, B0); PG8_MMA(0, 1, At, B1); PG8_BAR; PG8_SCHED;
            PG8_LDA(At, 0, 1); PG8_STAGE(PG8_SB(0, 0), b2, voffB); PG8_STAGE(PG8_SB(0, 1), b2 + hstep, voffB); PG8_STAGE(PG8_SA(0, 0), a2, voffA);
            PG8_WAIT_V(8); PG8_WAIT_L(0); PG8_BAR; PG8_MMA(1, 0, At, B0); PG8_MMA(1, 1, At, B1); PG8_BAR; PG8_SCHED;
            PG8_LDB(B0, 1, 0); PG8_LDB(B1, 1, 1); PG8_SCHED; PG8_LDA(At, 1, 0); PG8_STAGE(PG8_SA(0, 1), a2 + hstep, voffA);
            PG8_WAIT_V(8); PG8_WAIT_L(0); PG8_BAR; PG8_MMA(0, 0, At, B0); PG8_MMA(0, 1, At, B1); PG8_BAR; PG8_SCHED;
            PG8_LDA(At, 1, 1); PG8_STAGE(PG8_SB(1, 0), b3, voffB); PG8_STAGE(PG8_SB(1, 1), b3 + hstep, voffB); PG8_STAGE(PG8_SA(1, 0), a3, voffA);
            PG8_WAIT_V(8); PG8_WAIT_L(0); PG8_BAR; PG8_MMA(1, 0, At, B0); PG8_MMA(1, 1, At, B1); PG8_BAR; PG8_SCHED;
            } else {
            PG8_LDB(B0, 0, 0); PG8_SCHED; PG8_LDA(At, 0, 0); PG8_STAGE(PG8_SA(1, 1), a1 + hstep, voffA);
            PG8_WAIT_L(8); PG8_BAR; PG8_WAIT_L(0); PG8_MMA(0, 0, At, B0); PG8_BAR; PG8_SCHED;
            PG8_LDB(B1, 0, 1); PG8_STAGE(PG8_SB(0, 0), b2, voffB);
            PG8_BAR; PG8_WAIT_L(0); PG8_MMA(0, 1, At, B1); PG8_BAR;
            PG8_LDA(At, 0, 1); PG8_STAGE(PG8_SA(0, 0), a2, voffA);
            PG8_BAR; PG8_WAIT_L(0); PG8_MMA(1, 0, At, B0); PG8_BAR; PG8_SCHED;
            PG8_STAGE(PG8_SB(0, 1), b2 + hstep, voffB);
            PG8_WAIT_V(6); PG8_BAR; PG8_MMA(1, 1, At, B1); PG8_BAR;
            PG8_LDB(B0, 1, 0); PG8_SCHED; PG8_LDA(At, 1, 0); PG8_STAGE(PG8_SA(0, 1), a2 + hstep, voffA);
            PG8_WAIT_L(8); PG8_BAR; PG8_WAIT_L(0); PG8_MMA(0, 0, At, B0); PG8_BAR; PG8_SCHED;
            PG8_LDB(B1, 1, 1); PG8_STAGE(PG8_SB(1, 0), b3, voffB);
            PG8_BAR; PG8_WAIT_L(0); PG8_MMA(0, 1, At, B1); PG8_BAR;
            PG8_LDA(At, 1, 1); PG8_STAGE(PG8_SA(1, 0), a3, voffA);
            PG8_BAR; PG8_WAIT_L(0); PG8_MMA(1, 0, At, B0); PG8_BAR; PG8_SCHED;
            PG8_STAGE(PG8_SB(1, 1), b3 + hstep, voffB);
            PG8_WAIT_V(6); PG8_BAR; PG8_MMA(1, 1, At, B1); PG8_BAR;
            }
        }
        if constexpr (ALIGN_EPI) { if (wr == 0) PG8_BAR; }
        if constexpr (!Epi::AFTER_DRAIN) { E(acc, cur, wr, wc, fr, fq); S.done(cur); }
        if (!has_next) break;
#pragma unroll
        for (int a = 0; a < 2; ++a)
#pragma unroll
            for (int b = 0; b < 2; ++b)
#pragma unroll
                for (int m = 0; m < 4; ++m)
#pragma unroll
                    for (int n = 0; n < 2; ++n) acc[a][b][m][n] = (f32x4){0.f, 0.f, 0.f, 0.f};
        cur = nxt; cA = nA; cB = nB; ++ui;
        if constexpr (ALIGN_EPI) { if (wr == 1) PG8_BAR; }
    }
    PG8_WAIT_V(0);
    if constexpr (!ALIGN_EPI) { if (wr == 0) PG8_BAR; }
    PG8_BAR;
    if constexpr (Epi::AFTER_DRAIN) { E.fused(acc, cur, wr, wc, fr, fq, lds, wid, lane); S.done(cur); }
#undef PG8_SA
#undef PG8_SB
#undef PG8_STAGE
#undef PG8_LDA
#undef PG8_LDB
#undef PG8_MMA
#undef PG8_WAIT_V
#undef PG8_WAIT_L
#undef PG8_BAR
#undef PG8_SCHED
}
}
namespace cg = cooperative_groups;
#define LAS __attribute__((address_space(3)))
typedef unsigned short bf16;
typedef float f32x4 __attribute__((ext_vector_type(4)));
typedef unsigned u32x4 __attribute__((ext_vector_type(4)));
typedef unsigned u32x2 __attribute__((ext_vector_type(2)));

constexpr int NWAVES = 8, NTHREADS = 512;
constexpr int D = 1024, TP = 16384;
constexpr int FFN = 2816;
constexpr float EPS = 1e-6f;
enum { ST_H = 0, ST_G1N, ST_NA, ST_G1R, ST_R1, ST_R2, ST_HGN, ST_GATES, ST_G2, ST_G3, ST_G4, ST_N1, ST_G5, ST_G6, ST_N2, NSTEP };
constexpr int NPHASE = 2 + 2 * NSTEP;
constexpr int LDS_BYTES = 147456;
#ifndef DIS_MASK
#define DIS_MASK 0
#endif
constexpr unsigned DIS = DIS_MASK;

constexpr size_t MiB = 1u << 20;
constexpr size_t WS_CTL = 0, WS_MODP = 64 * 1024, WS_MOD = 704 * 1024;
constexpr size_t WS_WIN = 1 * MiB, WS_WNA = 23 * MiB, WS_WRET = 25 * MiB, WS_WOUT = 29 * MiB, WS_WFI = 31 * MiB, WS_WFO = 42 * MiB;
constexpr size_t WS_KT = 48 * MiB, WS_HB = 48 * MiB  , WS_MERGED = 48 * MiB, WS_F = 48 * MiB;
constexpr size_t WS_NQ = 80 * MiB, WS_H2 = 80 * MiB;
constexpr size_t WS_NK = 112 * MiB, WS_NV = 144 * MiB, WS_VT = 112 * MiB, WS_SG = 112 * MiB, WS_ACT = 112 * MiB;
constexpr size_t WS_HA = 176 * MiB  , WS_O = 176 * MiB, WS_OUTMIX = 176 * MiB, WS_END = 256 * MiB;

__device__ __forceinline__ float wave_sum(float v) {
#pragma unroll
    for (int o = 1; o < 64; o <<= 1) v += __shfl_xor(v, o);
    return v;
}
__device__ __forceinline__ float bf2f(unsigned short b) { return __uint_as_float((unsigned)b << 16); }
__device__ __forceinline__ unsigned pk2(float lo, float hi) { return pg8::cvt_pk_bf16(lo, hi); }
__device__ __forceinline__ float rdlane(float v, int l) { return __int_as_float(__builtin_amdgcn_readlane(__float_as_int(v), l)); }

__device__ __forceinline__ void transpose_item(const float* W, int K, int N, bf16* WT, int k0, int n0, int drow0, LAS float* scr, int lane) {
#pragma unroll 8
    for (int i = 0; i < 32; ++i) { const int kk = 2 * i + (lane >> 5); scr[kk * 33 + (lane & 31)] = W[(size_t)(k0 + kk) * N + n0 + (lane & 31)]; }
    asm volatile("s_waitcnt lgkmcnt(0)" ::: "memory");
    const int c = lane & 7;
#pragma unroll
    for (int j = 0; j < 4; ++j) { const int n = (lane >> 3) + 8 * j; const LAS float* s = scr + (8 * c) * 33 + n;
        u32x4 o; o.x = pk2(s[0 * 33], s[1 * 33]); o.y = pk2(s[2 * 33], s[3 * 33]); o.z = pk2(s[4 * 33], s[5 * 33]); o.w = pk2(s[6 * 33], s[7 * 33]);
        *(u32x4*)(WT + (size_t)(drow0 + n) * K + k0 + 8 * c) = o; }
    asm volatile("s_waitcnt lgkmcnt(0)" ::: "memory");
}

#define RLX_AGENT __ATOMIC_RELAXED, __HIP_MEMORY_SCOPE_AGENT
#define XB_TMO      128
#define XB_XCNT(j)  (256  + 64 * (j))
#define XB_XSUB(j)  (1280 + 64 * (j))
#define XB_XGEN(j)  (2304 + 64 * (j))
#define XB_TOP      3328
#define XB_TOPGEN   3392
#define XCD_BAR_WORDS 3456
#define XB_SPIN_CAP (1u << 18)

__device__ __forceinline__ unsigned xb_ld(unsigned* p)              { return __hip_atomic_load(p, __ATOMIC_RELAXED, __HIP_MEMORY_SCOPE_AGENT); }
__device__ __forceinline__ unsigned xb_add(unsigned* p, unsigned v) { return __hip_atomic_fetch_add(p, v, __ATOMIC_RELAXED, __HIP_MEMORY_SCOPE_AGENT); }
__device__ __forceinline__ unsigned xb_xcc_id() { return (unsigned)__builtin_amdgcn_s_getreg((3 << 11) | 20) & 0xFu; }
#define XB_SPIN(cond, bar) do { unsigned _sp = 0; while (cond) { __builtin_amdgcn_s_sleep(1); \
    if ((++_sp & 255u) == 0u) { if (xb_ld(&(bar)[XB_TMO])) break; if (_sp > XB_SPIN_CAP) { atomicAdd(&(bar)[XB_TMO], 1u); break; } } } } while (0)

struct XcdBarrier {
    unsigned* bar; unsigned x;
    volatile LAS unsigned* st;
};

__device__ __forceinline__ XcdBarrier xcd_barrier_post(unsigned* bar, volatile LAS unsigned* st) {
    XcdBarrier b; b.bar = bar; b.x = xb_xcc_id(); b.st = st;
    if (threadIdx.x == 0) (void)xb_add(&bar[XB_XCNT(b.x)], 1u);
    return b;
}
__device__ __forceinline__ void xcd_barrier_complete(unsigned* bar, unsigned x, unsigned& nloc, unsigned& nx) {
    const unsigned G = gridDim.x * gridDim.y * gridDim.z;
    unsigned sum, cnt, mine, sp = 0u;
    for (;;) {
        sum = 0u; cnt = 0u; mine = 0u;
#pragma unroll
        for (unsigned j = 0; j < 16; ++j) { const unsigned c = xb_ld(&bar[XB_XCNT(j)]); sum += c; cnt += (c > 0u) ? 1u : 0u; mine = (j == x) ? c : mine; }
        if (sum == G) break;
        __builtin_amdgcn_s_sleep(1);
        if ((++sp & 255u) == 0u) { if (xb_ld(&bar[XB_TMO])) break; if (sp > XB_SPIN_CAP) { atomicAdd(&bar[XB_TMO], 1u); break; } }
    }
    nloc = mine > 0u ? mine : 1u; nx = cnt > 0u ? cnt : 1u;
}

__device__ __forceinline__ void xcd_barrier(const XcdBarrier& b) {
    asm volatile("s_waitcnt vmcnt(0)" ::: "memory");
    __syncthreads();
    if (threadIdx.x == 0) {
        unsigned* bar = b.bar;
        __builtin_amdgcn_s_waitcnt(0);
        unsigned nloc = b.st[0], nx = b.st[1];
        if (nloc == 0u) { xcd_barrier_complete(bar, b.x, nloc, nx); b.st[0] = nloc; b.st[1] = nx; }
        const unsigned old = xb_add(&bar[XB_XSUB(b.x)], 1u);
        const unsigned gen = old / nloc;
        if (old + 1u == (gen + 1u) * nloc) {
            __builtin_amdgcn_fence(__ATOMIC_RELEASE, "agent");
            asm volatile("s_waitcnt vmcnt(0)" ::: "memory");
            const unsigned og = xb_add(&bar[XB_TOP], 1u);
            const unsigned tg = og / nx;
            if (og + 1u == (tg + 1u) * nx) xb_add(&bar[XB_TOPGEN], 1u);
            else XB_SPIN(xb_ld(&bar[XB_TOPGEN]) == tg, bar);
            __builtin_amdgcn_fence(__ATOMIC_ACQUIRE, "agent");
            xb_add(&bar[XB_XGEN(b.x)], 1u);
            asm volatile("s_waitcnt vmcnt(0)" ::: "memory");
        } else {
            XB_SPIN(xb_ld(&bar[XB_XGEN(b.x)]) == gen, bar);
            __builtin_amdgcn_fence(__ATOMIC_ACQUIRE, "agent");
            asm volatile("s_waitcnt vmcnt(0)" ::: "memory");
        }
    }
    __syncthreads();
}

constexpr int CW_BAR = 4096;
constexpr int RING_BYTES = 131072, MISC_OFF = RING_BYTES + 320;
constexpr size_t CTL_ZERO_BYTES = 64 * 1024;
#ifndef ONE_LAUNCH
#define ONE_LAUNCH 1
#endif
typedef float f32x16 __attribute__((ext_vector_type(16)));
typedef float f32x2 __attribute__((ext_vector_type(2)));
typedef short bf16x8 __attribute__((ext_vector_type(8)));
typedef short s16x2 __attribute__((ext_vector_type(2)));
typedef __bf16 bf16x2_t __attribute__((ext_vector_type(2)));
typedef unsigned long long u64x2 __attribute__((ext_vector_type(2)));
#define MFMA32(a, b, c) __builtin_amdgcn_mfma_f32_32x32x16_bf16((a), (b), (c), 0, 0, 0)
__device__ __forceinline__ void atomic_add_bf16x2(bf16* p, float a, float b) {
    f32x2 v = {a, b}; bf16x2_t w = __builtin_convertvector(v, bf16x2_t);
    __builtin_amdgcn_global_atomic_fadd_v2bf16((__attribute__((address_space(1))) s16x2*)p, __builtin_bit_cast(s16x2, w));
}
__device__ __forceinline__ float log2_sigmoid(float x) { return -log1pf(expf(-x)) * 1.4426950408889634f; }

__device__ __forceinline__ void h_rows(const float* xin, const float* MOD, const float* gain, bf16* Hout, int seq0, int seqlen, int gw, int NGW, int lane) {
    for (int t = gw; t < TP; t += NGW) { const float* mod = MOD + (size_t)(seq0 + t / seqlen) * 6144;
        const f32x4* xr = (const f32x4*)(xin + (size_t)t * D) + lane; f32x4 v[4]; float ss = 0.f;
#pragma unroll
        for (int j = 0; j < 4; ++j) { v[j] = xr[64 * j]; ss += (v[j].x * v[j].x + v[j].y * v[j].y) + (v[j].z * v[j].z + v[j].w * v[j].w); }
        const float rstd = 1.0f / sqrtf(wave_sum(ss) * (1.f / D) + EPS);
        u32x2* o8 = (u32x2*)(Hout + (size_t)t * D) + lane;
#pragma unroll
        for (int j = 0; j < 4; ++j) { const int c = 4 * lane + 256 * j; const f32x4 g = *(const f32x4*)(gain + c), sh = *(const f32x4*)(mod + c), sc = *(const f32x4*)(mod + 1024 + c);
            const f32x4 h = v[j] * rstd * g * (sc + 1.0f) + sh; u32x2 w; w.x = pk2(h.x, h.y); w.y = pk2(h.z, h.w); o8[64 * j] = w; }
    }
}

__device__ __forceinline__ void ret_intra(const bf16* QB, const bf16* KB, const bf16* VT, bf16* Ob, const float* decay_logit, int lane, int wave, int G) {
    const int r32 = lane & 31, hh = lane >> 5, qt = wave >> 1, dh = wave & 1, qi = 32 * qt + r32;
    for (int un = blockIdx.x; un < 512; un += G) { const int cg = un >> 2, h = un & 3;
        const float L2f = log2_sigmoid(decay_logit[h]), L2b = log2_sigmoid(decay_logit[4 + h]);
        f32x16 P[4];
#pragma unroll
        for (int kt = 0; kt < 4; ++kt)
#pragma unroll
            for (int g = 0; g < 16; ++g) P[kt][g] = 0.f;
        const bf16x8* qb = (const bf16x8*)QB + ((size_t)(h * 512 + cg * 4 + qt) * 16) * 64 + lane;
        const bf16x8* kb = (const bf16x8*)KB + ((size_t)(h * 512 + cg * 4) * 16) * 64 + lane;
#pragma unroll 4
        for (int s = 0; s < 16; ++s) { const bf16x8 bq = qb[s * 64];
#pragma unroll
            for (int kt = 0; kt < 4; ++kt) P[kt] = MFMA32(kb[(kt * 16 + s) * 64], bq, P[kt]); }
        bf16x8 pb[4][2];
#pragma unroll
        for (int kt = 0; kt < 4; ++kt) {
#pragma unroll
            for (int g = 0; g < 16; ++g) { const int kj = 32 * kt + (g & 3) + 8 * (g >> 2) + 4 * hh; const int d = qi - kj;
                P[kt][g] *= __builtin_amdgcn_exp2f(d >= 0 ? (float)d * L2f : (float)(-d) * L2b); }
#pragma unroll
            for (int s2 = 0; s2 < 2; ++s2) { u32x4 w; w.x = pk2(P[kt][8 * s2 + 0], P[kt][8 * s2 + 1]); w.y = pk2(P[kt][8 * s2 + 2], P[kt][8 * s2 + 3]);
                w.z = pk2(P[kt][8 * s2 + 4], P[kt][8 * s2 + 5]); w.w = pk2(P[kt][8 * s2 + 6], P[kt][8 * s2 + 7]); pb[kt][s2] = __builtin_bit_cast(bf16x8, w); }
        }
        const size_t tok = (size_t)cg * 128 + qi;
        for (int dvt = 0; dvt < 8; ++dvt) { const int dvtile = 8 * dh + dvt; f32x16 o;
#pragma unroll
            for (int g = 0; g < 16; ++g) o[g] = 0.f;
            const unsigned long long* vb = (const unsigned long long*)VT + (((size_t)(h * 128 + cg) * 16 + dvtile) * 8) * 128 + r32 * 2 + hh;
#pragma unroll
            for (int kt = 0; kt < 4; ++kt)
#pragma unroll
                for (int s2 = 0; s2 < 2; ++s2) { const int sb = 2 * kt + s2; u64x2 t2; t2.x = vb[sb * 128]; t2.y = vb[sb * 128 + 64];
                    o = MFMA32(__builtin_bit_cast(bf16x8, t2), pb[kt][s2], o); }
            bf16* op = Ob + tok * 2048 + 512 * h + 32 * dvtile + 4 * hh;
#pragma unroll
            for (int g4 = 0; g4 < 4; ++g4) { const unsigned long long w = (unsigned long long)pk2(o[4 * g4], o[4 * g4 + 1]) | ((unsigned long long)pk2(o[4 * g4 + 2], o[4 * g4 + 3]) << 32);
#ifdef R1_PLAIN_STORE
                *(unsigned long long*)(op + 8 * g4) = w; }
#else
                __hip_atomic_store((unsigned long long*)(op + 8 * g4), w, __ATOMIC_RELAXED, __HIP_MEMORY_SCOPE_AGENT); }
#endif
        }
    }
}

__device__ __forceinline__ void ret_scan(LAS unsigned char* lds, const bf16* QB, const bf16* KT, const bf16* VT, bf16* Ob, const float* decay_logit, int nseq, int seqlen, int tid, int lane, int wave, int G) {
    constexpr int ST_STRIDE = 528, ST_BYTES = 64 * ST_STRIDE, VL_OFF = 2 * ST_BYTES, ZT_OFF = VL_OFF + 2 * 16384;
    const int nc = seqlen >> 7, r32 = lane & 31, hh = lane >> 5, dt = wave & 1, tt = wave >> 1;
    const bf16x8* QBv = (const bf16x8*)QB; const bf16x8* KTv = (const bf16x8*)KT; const u32x4* VTv = (const u32x4*)VT;
    for (int item = blockIdx.x; item < nseq * 64; item += G) { const int sq = item >> 6, h = (item >> 4) & 3, dir = (item >> 3) & 1, sl = item & 7;
        const float L2 = log2_sigmoid(decay_logit[dir * 4 + h]); const float gC = __builtin_amdgcn_exp2f(128.f * L2);
        LAS float* ZT = (LAS float*)(lds + ZT_OFF);
        if (tid < 128) ZT[tid] = __builtin_amdgcn_exp2f(L2 * (dir == 0 ? (float)(127 - tid) : (float)tid));
        for (int i = tid; i < ST_BYTES / 16; i += NTHREADS) ((LAS u32x4*)lds)[i] = (u32x4){0u, 0u, 0u, 0u};
        const int qi = 32 * tt + r32; const float xi = __builtin_amdgcn_exp2f(L2 * (dir == 0 ? (float)(qi + 1) : (float)(128 - qi)));
        const int cbase = sq * nc;
        f32x16 S0, S1;
#pragma unroll
        for (int g = 0; g < 16; ++g) { S0[g] = 0.f; S1[g] = 0.f; }
        bf16x8 Qf[16], Kf[8]; u32x4 Vr[2];
        int cg = cbase + (dir == 0 ? 0 : nc - 1);
#pragma unroll
        for (int s = 0; s < 16; ++s) Qf[s] = QBv[((size_t)(h * 512 + cg * 4 + tt) * 16 + s) * 64 + lane];
#pragma unroll
        for (int s = 0; s < 8; ++s) Kf[s] = KTv[(((size_t)(h * 128 + cg) * 8 + wave) * 8 + s) * 64 + lane];
#pragma unroll
        for (int k = 0; k < 2; ++k) Vr[k] = VTv[((size_t)(h * 128 + cg) * 16 + 2 * sl) * 512 + tid + 512 * k];
        __syncthreads();
        for (int i = 0; i < nc; ++i) { const int buf = i & 1; const int in = (i + 1 < nc) ? i + 1 : i; const int cgn = cbase + (dir == 0 ? in : nc - 1 - in);
#pragma unroll
            for (int k = 0; k < 2; ++k) { const int u = tid + 512 * k, j0 = 16 * ((u >> 6) & 7) + 8 * ((u >> 5) & 1); float f[8]; pg8::unpack8(Vr[k], f);
                const f32x4 z0 = *(const LAS f32x4*)(ZT + j0), z1 = *(const LAS f32x4*)(ZT + j0 + 4);
                f[0] *= z0.x; f[1] *= z0.y; f[2] *= z0.z; f[3] *= z0.w; f[4] *= z1.x; f[5] *= z1.y; f[6] *= z1.z; f[7] *= z1.w;
                *(LAS u32x4*)(lds + VL_OFF + buf * 16384 + u * 16) = pg8::pack8(f); }
#pragma unroll
            for (int k = 0; k < 2; ++k) Vr[k] = VTv[((size_t)(h * 128 + cgn) * 16 + 2 * sl) * 512 + tid + 512 * k];
            __syncthreads();
            f32x16 cr;
#pragma unroll
            for (int g = 0; g < 16; ++g) cr[g] = 0.f;
            { const LAS unsigned char* stb = lds + buf * ST_BYTES + (32 * dt + r32) * ST_STRIDE + hh * 16;
#pragma unroll
              for (int s = 0; s < 16; ++s) cr = MFMA32(*(const LAS bf16x8*)(stb + s * 32), Qf[s], cr); }
#pragma unroll
            for (int s = 0; s < 16; ++s) Qf[s] = QBv[((size_t)(h * 512 + cgn * 4 + tt) * 16 + s) * 64 + lane];
            { bf16* op = Ob + ((size_t)cg * 128 + qi) * 2048 + 512 * h + 64 * sl + 32 * dt + 4 * hh;
#pragma unroll
              for (int g4 = 0; g4 < 4; ++g4) { atomic_add_bf16x2(op + 8 * g4, cr[4 * g4] * xi, cr[4 * g4 + 1] * xi); atomic_add_bf16x2(op + 8 * g4 + 2, cr[4 * g4 + 2] * xi, cr[4 * g4 + 3] * xi); } }
#pragma unroll
            for (int g = 0; g < 16; ++g) { S0[g] *= gC; S1[g] *= gC; }
            { const LAS unsigned char* vlb = lds + VL_OFF + buf * 16384 + lane * 16;
#pragma unroll
              for (int s = 0; s < 8; ++s) { S0 = MFMA32(Kf[s], *(const LAS bf16x8*)(vlb + s * 1024), S0); S1 = MFMA32(Kf[s], *(const LAS bf16x8*)(vlb + (8 + s) * 1024), S1); } }
#pragma unroll
            for (int s = 0; s < 8; ++s) Kf[s] = KTv[(((size_t)(h * 128 + cgn) * 8 + wave) * 8 + s) * 64 + lane];
            { LAS unsigned char* wb = lds + (buf ^ 1) * ST_BYTES + r32 * ST_STRIDE + 64 * wave + 8 * hh;
#pragma unroll
              for (int g4 = 0; g4 < 4; ++g4) { u32x2 w; w.x = pk2(S0[4 * g4], S0[4 * g4 + 1]); w.y = pk2(S0[4 * g4 + 2], S0[4 * g4 + 3]); *(LAS u32x2*)(wb + 16 * g4) = w;
                  w.x = pk2(S1[4 * g4], S1[4 * g4 + 1]); w.y = pk2(S1[4 * g4 + 2], S1[4 * g4 + 3]); *(LAS u32x2*)(wb + 32 * ST_STRIDE + 16 * g4) = w; } }
            cg = cgn;
        }
        __syncthreads();
    }
}

struct Args { const float* in[19]; float* out; unsigned char* ws; int ph_lo, ph_hi; };

__global__ void __launch_bounds__(NTHREADS, 2) fwd(Args args) {
    extern __shared__ __attribute__((aligned(16))) unsigned char lds_raw[];
    LAS unsigned char* lds = (LAS unsigned char*)lds_raw;
    for (int u = threadIdx.x; u < (LDS_BYTES - RING_BYTES) / 4; u += NTHREADS) ((LAS unsigned*)(lds + RING_BYTES))[u] = 0u;
    __syncthreads();
    if (args.ph_hi - args.ph_lo > 1) (void)xcd_barrier_post((unsigned*)(args.ws + WS_CTL) + CW_BAR, (volatile LAS unsigned*)(lds + MISC_OFF) + 8);
    for (int ph = args.ph_lo; ph < args.ph_hi; ++ph) {
    int tid = threadIdx.x; asm volatile("" : "+v"(tid));
    const int lane = tid & 63, wave = __builtin_amdgcn_readfirstlane(tid >> 6);
    const int G = gridDim.x, gw = blockIdx.x * NWAVES + wave, NGW = G * NWAVES;
    size_t zoff = 0; asm volatile("" : "+s"(zoff)); unsigned char* ws = args.ws + zoff;
    const float* x_prompt = args.in[0]; const float* x_sample = args.in[1]; const float* c_prompt = args.in[2]; const float* c_sample = args.in[3];
    const float* w_mod = args.in[4]; const float* b_mod = args.in[5]; const float* g_pre_mix = args.in[6]; const float* w_in = args.in[7];
    const float* rpb = args.in[8]; const float* decay_logit = args.in[9]; const float* ret_gn = args.in[10]; const float* w_up_na = args.in[11];
    const float* w_up_ret = args.in[12]; const float* w_out = args.in[13]; const float* g_post_mix = args.in[14]; const float* g_pre_ffn = args.in[15];
    const float* w_ffn_in = args.in[16]; const float* w_ffn_out = args.in[17]; const float* g_post_ffn = args.in[18];
    float* MODP = (float*)(ws + WS_MODP); float* MOD = (float*)(ws + WS_MOD);
    bf16* WIN = (bf16*)(ws + WS_WIN); bf16* WNA = (bf16*)(ws + WS_WNA); bf16* WRET = (bf16*)(ws + WS_WRET); bf16* WOUT = (bf16*)(ws + WS_WOUT);
    bf16* WFI = (bf16*)(ws + WS_WFI); bf16* WFO = (bf16*)(ws + WS_WFO);
    bf16* HA = (bf16*)(ws + WS_HA); bf16* HB = (bf16*)(ws + WS_HB); bf16* NQ = (bf16*)(ws + WS_NQ); bf16* NK = (bf16*)(ws + WS_NK); bf16* NV = (bf16*)(ws + WS_NV);
    bf16* KT = (bf16*)(ws + WS_KT); bf16* VT = (bf16*)(ws + WS_VT);
    bf16* Ob = (bf16*)(ws + WS_O); bf16* SG = (bf16*)(ws + WS_SG); bf16* MERGED = (bf16*)(ws + WS_MERGED);
    float* OUTMIX = (float*)(ws + WS_OUTMIX); bf16* H2 = (bf16*)(ws + WS_H2); bf16* ACT = (bf16*)(ws + WS_ACT); float* Fb = (float*)(ws + WS_F);
        if (ph == 0 && !(DIS & 1)) {
            LAS float* scr = (LAS float*)(lds + wave * 16384);
            constexpr int I_IN = 16 * 352, I_NA = 16 * 32, I_RET = 32 * 32, I_OUT = 16 * 32, I_FI = 16 * 176, I_FO = 44 * 32, I_MOD = 96 * 8;
            constexpr int NITEMS = I_IN + I_NA + I_RET + I_OUT + I_FI + I_FO + I_MOD;
            for (int it = gw; it < NITEMS; it += NGW) {
                int r = it;
                if (r < I_IN) { const int nb = r % 352, kb = r / 352; transpose_item(w_in, 1024, 11264, WIN, 64 * kb, 32 * nb, 32 * nb, scr, lane); continue; } r -= I_IN;
                if (r < I_NA) { const int nb = r % 32, kb = r / 32; transpose_item(w_up_na, 1024, 1024, WNA, 64 * kb, 32 * nb, 32 * nb, scr, lane); continue; } r -= I_NA;
                if (r < I_RET) { const int nb = r % 32, kb = r / 32; transpose_item(w_up_ret, 2048, 1024, WRET, 64 * kb, 32 * nb, 32 * nb, scr, lane); continue; } r -= I_RET;
                if (r < I_OUT) { const int nb = r % 32, kb = r / 32; transpose_item(w_out, 1024, 1024, WOUT, 64 * kb, 32 * nb, 32 * nb, scr, lane); continue; } r -= I_OUT;
                if (r < I_FI) { const int nb = r % 176, kb = r / 176; const int n0 = 32 * nb; const int j = (n0 < FFN) ? n0 : n0 - FFN;
                    const int drow = 256 * (j / 128) + (j % 128) + ((n0 < FFN) ? 0 : 128);
                    transpose_item(w_ffn_in, 1024, 2 * FFN, WFI, 64 * kb, n0, drow, scr, lane); continue; } r -= I_FI;
                if (r < I_FO) { const int nb = r % 32, kb = r / 32; transpose_item(w_ffn_out, FFN, 1024, WFO, 64 * kb, 32 * nb, 32 * nb, scr, lane); continue; } r -= I_FO;
                { const int strip = r % 96, kc = r / 96; const int j = strip * 64 + lane; float a0 = 0.f, a1 = 0.f, a2 = 0.f;
                    for (int k = kc * 128; k < kc * 128 + 128; ++k) { const float w = w_mod[(size_t)k * 6144 + j];
                        const float c0 = c_prompt[k], c1 = c_prompt[1024 + k], c2 = c_sample[k];
                        a0 += c0 * pg8::sigm(c0) * w; a1 += c1 * pg8::sigm(c1) * w; a2 += c2 * pg8::sigm(c2) * w; }
                    MODP[(kc * 3 + 0) * 6144 + j] = a0; MODP[(kc * 3 + 1) * 6144 + j] = a1; MODP[(kc * 3 + 2) * 6144 + j] = a2; }
            }
        } else if (ph == 1 && !(DIS & 2)) {
            for (int i = blockIdx.x * NTHREADS + tid; i < 3 * 6144; i += G * NTHREADS) { float s = b_mod[i % 6144];
#pragma unroll
                for (int kc = 0; kc < 8; ++kc) s += MODP[kc * 3 * 6144 + i];
                MOD[i] = s; }
        } else if (ph >= 2) {
            const int pass = (ph - 2) / NSTEP, step = (ph - 2) % NSTEP;
            const float* xin = pass == 0 ? x_sample : x_prompt; float* outp = args.out + (pass == 0 ? (size_t)TP * D : 0);
            const int seqlen = pass == 0 ? 16384 : 8192, seq0 = pass == 0 ? 2 : 0, nseq = pass == 0 ? 1 : 2;
            bf16* QB = (bf16*)outp; bf16* KB = QB + (size_t)TP * 1024; bf16* TNA = QB;
            if ((step == ST_H || step == ST_HGN) && !(DIS & 4)) {
                h_rows(xin, MOD, g_pre_mix, step == ST_H ? HA : HB, seq0, seqlen, gw, NGW, lane);
                if (step == ST_HGN) {
                    for (int t = gw; t < TP; t += NGW) {
#pragma unroll
                        for (int h = 0; h < 4; ++h) { bf16* p = Ob + (size_t)t * 2048 + 512 * h + 8 * lane; float f[8]; pg8::unpack8(*(const u32x4*)p, f);
                            float s = 0.f;
#pragma unroll
                            for (int e = 0; e < 8; ++e) s += f[e];
                            const float mu = wave_sum(s) * (1.f / 512.f); float q = 0.f;
#pragma unroll
                            for (int e = 0; e < 8; ++e) { f[e] -= mu; q += f[e] * f[e]; }
                            const float rstd = 1.0f / sqrtf(wave_sum(q) * (1.f / 512.f) + EPS);
                            const f32x4 g0 = *(const f32x4*)(ret_gn + 512 * h + 8 * lane), g1 = *(const f32x4*)(ret_gn + 512 * h + 8 * lane + 4);
                            f[0] *= rstd * g0.x; f[1] *= rstd * g0.y; f[2] *= rstd * g0.z; f[3] *= rstd * g0.w; f[4] *= rstd * g1.x; f[5] *= rstd * g1.y; f[6] *= rstd * g1.z; f[7] *= rstd * g1.w;
                            *(u32x4*)p = pg8::pack8(f); }
                    }
                }
            } else if ((step == ST_G1N || step == ST_G1R || step == ST_GATES || step == ST_G2 || step == ST_G3 || step == ST_G5) && !(DIS & 8)) {
                const int nparts = (step == ST_G1R || step == ST_GATES) ? 2 : 1;
                for (int part = 0; part < nparts; ++part) {
                    pg8::Gemm g; pg8::EpiBf E; E.o0 = nullptr; E.o1 = nullptr; E.o2 = nullptr; E.a1 = nullptr; E.a2 = nullptr; E.ldo = 1024; E.ld1 = 2048; E.ld2 = 1024; E.seqmask = seqlen - 1;
                    if (step == ST_G1N)        { g = pg8::Gemm{HA, WIN, TP, 3072, 1024}; E.mode = 0; E.o0 = NQ; E.o1 = NK; E.o2 = NV; }
                    else if (step == ST_G1R) {
                        if (part == 0)         { g = pg8::Gemm{HA, WIN + (size_t)3072 * 1024, TP, 2048, 1024}; E.mode = 1; E.o0 = QB; E.o1 = KB; }
                        else                   { g = pg8::Gemm{WIN + (size_t)4096 * 1024, HA, 3072, TP, 1024}; E.mode = 7; E.o0 = KT; E.o1 = VT; }
                    } else if (step == ST_GATES) {
                        if (part == 0)         { g = pg8::Gemm{HB, WIN + (size_t)9216 * 1024, TP, 2048, 1024}; E.mode = 2; E.o0 = SG; E.ldo = 2048; }
                        else                   { g = pg8::Gemm{HB, WIN + (size_t)7168 * 1024, TP, 2048, 1024}; E.mode = 3; E.o0 = Ob; E.ldo = 2048; E.a1 = Ob; E.ld1 = 2048; }
                    }
                    else if (step == ST_G2)    { g = pg8::Gemm{NQ, WNA, TP, 1024, 1024}; E.mode = 4; E.o0 = TNA; E.ldo = 1024; E.a1 = SG; E.ld1 = 2048; }
                    else if (step == ST_G3)    { g = pg8::Gemm{Ob, WRET, TP, 1024, 2048}; E.mode = 5; E.o0 = MERGED; E.ldo = 1024; E.a1 = SG + 1024; E.ld1 = 2048; E.a2 = TNA; E.ld2 = 1024; }
                    else                       { g = pg8::Gemm{H2, WFI, TP, 2 * FFN, 1024}; E.mode = 6; E.o0 = ACT; E.ldo = FFN; }
                    pg8::StaticOrder S; S.init(g.M, g.N, G, (int)blockIdx.x);
                    pg8::gemm_phase<pg8::EpiBf, pg8::StaticOrder, true, true>(lds, g, S, E);
                    if (part + 1 < nparts) { asm volatile("s_waitcnt vmcnt(0) lgkmcnt(0)" ::: "memory"); __syncthreads(); }
                }
            } else if ((step == ST_G4 || step == ST_G6) && !(DIS & 16)) {
                pg8::Gemm g; pg8::EpiF32 E;
                if (step == ST_G4) { g = pg8::Gemm{MERGED, WOUT, TP, 1024, 1024}; E.C = OUTMIX; E.ldc = 1024; }
                else               { g = pg8::Gemm{ACT, WFO, TP, 1024, FFN}; E.C = Fb; E.ldc = 1024; }
                pg8::StaticOrder S; S.init(g.M, g.N, G, (int)blockIdx.x);
                pg8::gemm_phase<pg8::EpiF32, pg8::StaticOrder, true, true>(lds, g, S, E);
            } else if (step == ST_NA && !(DIS & 32)) {
                const int rows = seqlen / 64;
                for (int un = blockIdx.x; un < 512; un += G) { const int R = un >> 1, h = (un & 1) * 8 + wave, c = lane, t = R * 64 + c;
                    const int r = R % rows, Rb = R - r; int rs = r - 4; rs = rs < 0 ? 0 : rs; rs = rs > rows - 8 ? rows - 8 : rs; int cs = c - 8; cs = cs < 0 ? 0 : cs; cs = cs > 48 ? 48 : cs;
                    float q[64], acc[64];
#pragma unroll
                    for (int i = 0; i < 8; ++i) { float f[8]; pg8::unpack8(*(const u32x4*)(NQ + (size_t)t * 1024 + 64 * h + 8 * i), f);
#pragma unroll
                        for (int e = 0; e < 8; ++e) { q[8 * i + e] = f[e]; acc[8 * i + e] = 0.f; } }
                    float mx = -INFINITY, l = 0.f;
                    for (int kr = 0; kr < 8; ++kr) for (int kc = 0; kc < 16; ++kc) { const int tk = (Rb + rs + kr) * 64 + cs + kc;
                        float s = rpb[(h * 15 + (rs + kr - r + 7)) * 31 + (cs + kc - c + 15)];
#pragma unroll
                        for (int i = 0; i < 8; ++i) { float f[8]; pg8::unpack8(*(const u32x4*)(NK + (size_t)tk * 1024 + 64 * h + 8 * i), f);
#pragma unroll
                            for (int e = 0; e < 8; ++e) s += q[8 * i + e] * f[e]; }
                        const float mn = fmaxf(mx, s), fo = __expf(mx - mn), p = __expf(s - mn); l = l * fo + p; mx = mn;
#pragma unroll
                        for (int i = 0; i < 8; ++i) { float f[8]; pg8::unpack8(*(const u32x4*)(NV + (size_t)tk * 1024 + 64 * h + 8 * i), f);
#pragma unroll
                            for (int e = 0; e < 8; ++e) acc[8 * i + e] = acc[8 * i + e] * fo + p * f[e]; } }
                    const float il = 1.0f / l;
#pragma unroll
                    for (int i = 0; i < 8; ++i) { float f[8];
#pragma unroll
                        for (int e = 0; e < 8; ++e) f[e] = acc[8 * i + e] * il;
                        *(u32x4*)(NQ + (size_t)t * 1024 + 64 * h + 8 * i) = pg8::pack8(f); }
                }
            } else if (step == ST_R1 && !(DIS & 64)) {
#ifdef PROBE_COPY_O
                for (size_t i = (size_t)blockIdx.x * NTHREADS + tid; i < (size_t)TP * 2048 / 8; i += (size_t)G * NTHREADS) ((u32x4*)Ob)[i] = (i & 1) ? ((const u32x4*)QB)[i] : ((const u32x4*)VT)[i];
#elif defined(PROBE_ZERO_O)
                for (size_t i = (size_t)blockIdx.x * NTHREADS + tid; i < (size_t)TP * 2048 / 8; i += (size_t)G * NTHREADS) ((u32x4*)Ob)[i] = (u32x4){0u, 0u, 0u, 0u};
#else
                ret_intra(QB, KB, VT, Ob, decay_logit, lane, wave, G);
#endif
            } else if (step == ST_R2 && !(DIS & 512)) {
                ret_scan(lds, QB, KT, VT, Ob, decay_logit, nseq, seqlen, tid, lane, wave, G);
            } else if (step == ST_N1 && !(DIS & 128)) {
                for (int t = gw; t < TP; t += NGW) { const float* mod = MOD + (size_t)(seq0 + t / seqlen) * 6144;
                    const f32x4* orow = (const f32x4*)(OUTMIX + (size_t)t * D) + lane; const f32x4* xr = (const f32x4*)(xin + (size_t)t * D) + lane; f32x4 v[4]; float ss = 0.f;
#pragma unroll
                    for (int j = 0; j < 4; ++j) { v[j] = orow[64 * j]; ss += (v[j].x * v[j].x + v[j].y * v[j].y) + (v[j].z * v[j].z + v[j].w * v[j].w); }
                    const float rstd = 1.0f / sqrtf(wave_sum(ss) * (1.f / D) + EPS); float s2 = 0.f;
                    f32x4* o4 = (f32x4*)(outp + (size_t)t * D) + lane;
#pragma unroll
                    for (int j = 0; j < 4; ++j) { const int c = 4 * lane + 256 * j; const f32x4 g = *(const f32x4*)(g_post_mix + c), gt = *(const f32x4*)(mod + 2048 + c);
                        v[j] = xr[64 * j] + gt * (v[j] * rstd * g); o4[64 * j] = v[j]; s2 += (v[j].x * v[j].x + v[j].y * v[j].y) + (v[j].z * v[j].z + v[j].w * v[j].w); }
                    const float rstd2 = 1.0f / sqrtf(wave_sum(s2) * (1.f / D) + EPS);
                    u32x2* o8 = (u32x2*)(H2 + (size_t)t * D) + lane;
#pragma unroll
                    for (int j = 0; j < 4; ++j) { const int c = 4 * lane + 256 * j; const f32x4 g = *(const f32x4*)(g_pre_ffn + c), sh = *(const f32x4*)(mod + 3072 + c), sc = *(const f32x4*)(mod + 4096 + c);
                        const f32x4 h = v[j] * rstd2 * g * (sc + 1.0f) + sh; u32x2 w; w.x = pk2(h.x, h.y); w.y = pk2(h.z, h.w); o8[64 * j] = w; }
                }
            } else if (step == ST_N2 && !(DIS & 256)) {
                for (int t = gw; t < TP; t += NGW) { const float* mod = MOD + (size_t)(seq0 + t / seqlen) * 6144;
                    const f32x4* frow = (const f32x4*)(Fb + (size_t)t * D) + lane; f32x4* o4 = (f32x4*)(outp + (size_t)t * D) + lane; f32x4 v[4]; float ss = 0.f;
#pragma unroll
                    for (int j = 0; j < 4; ++j) { v[j] = frow[64 * j]; ss += (v[j].x * v[j].x + v[j].y * v[j].y) + (v[j].z * v[j].z + v[j].w * v[j].w); }
                    const float rstd = 1.0f / sqrtf(wave_sum(ss) * (1.f / D) + EPS);
#pragma unroll
                    for (int j = 0; j < 4; ++j) { const int c = 4 * lane + 256 * j; const f32x4 g = *(const f32x4*)(g_post_ffn + c), gt = *(const f32x4*)(mod + 5120 + c);
                        o4[64 * j] = o4[64 * j] + gt * (v[j] * rstd * g); }
                }
            }
        }
        if (ph + 1 < args.ph_hi) {
            if (ph == 0) cg::this_grid().sync();
            else { XcdBarrier bar; bar.bar = (unsigned*)(args.ws + WS_CTL) + CW_BAR; bar.x = xb_xcc_id(); bar.st = (volatile LAS unsigned*)(lds + MISC_OFF) + 8; xcd_barrier(bar); }
        }
    }
}

extern "C" void kernel_launch(void* const* d_in, const int* in_sizes, int n_in, void* d_out, int out_size, void* d_ws, size_t ws_size, hipStream_t stream) {
    static int grid = 0;
    if (grid == 0) {
        if (n_in != 19 || out_size != 2 * TP * D || ws_size < WS_END) { fprintf(stderr, "kernel_launch: unexpected shapes (n_in %d out %d ws %zu)\n", n_in, out_size, ws_size); grid = -1; return; }
        int dev = 0, cus = 0;
        if (hipGetDevice(&dev) != hipSuccess || hipDeviceGetAttribute(&cus, hipDeviceAttributeMultiprocessorCount, dev) != hipSuccess) { grid = -1; return; }
        if (hipFuncSetAttribute((const void*)fwd, hipFuncAttributeMaxDynamicSharedMemorySize, LDS_BYTES) != hipSuccess) { fprintf(stderr, "kernel_launch: hipFuncSetAttribute failed\n"); grid = -1; return; }
        grid = cus;
    }
    if (grid < 0) return;
    Args a{};
    for (int i = 0; i < 19; ++i) a.in[i] = (const float*)d_in[i];
    a.out = (float*)d_out; a.ws = (unsigned char*)d_ws;
#if ONE_LAUNCH
    if (hipMemsetAsync((char*)d_ws + WS_CTL, 0, CTL_ZERO_BYTES, stream) != hipSuccess) { fprintf(stderr, "kernel_launch: memset failed\n"); return; }
    a.ph_lo = 0; a.ph_hi = NPHASE;
    void* kargs[] = {&a};
    const hipError_t e = hipLaunchCooperativeKernel((const void*)fwd, dim3(grid), dim3(NTHREADS), kargs, LDS_BYTES, stream);
    if (e != hipSuccess) fprintf(stderr, "kernel_launch: cooperative launch failed: %s (grid %d)\n", hipGetErrorString(e), grid);
#else
    for (int ph = 0; ph < NPHASE; ++ph) { a.ph_lo = ph; a.ph_hi = ph + 1; hipLaunchKernelGGL(fwd, dim3(grid), dim3(NTHREADS), LDS_BYTES, stream, a); }
#endif
}
```

```cpp
#include <hip/hip_runtime.h>
#include <hip/hip_cooperative_groups.h>
#include <cstdio>
#include <cstdint>
__device__ const float INVT[128] = {1.591549367e-01f, 1.481051445e-01f, 1.378225088e-01f, 1.282537729e-01f, 1.193493679e-01f, 1.110631898e-01f, 1.033522934e-01f, 9.617675841e-02f, 8.949939907e-02f, 8.328563720e-02f, 7.750328630e-02f, 7.212239504e-02f, 6.711508334e-02f, 6.245541945e-02f, 5.811926723e-02f, 5.408416688e-02f, 5.032921210e-02f, 4.683495685e-02f, 4.358330369e-02f, 4.055740312e-02f, 3.774158657e-02f, 3.512126207e-02f, 3.268286586e-02f, 3.041376173e-02f, 2.830219641e-02f, 2.633723244e-02f, 2.450869232e-02f, 2.280710265e-02f, 2.122365311e-02f, 1.975013874e-02f, 1.837892644e-02f, 1.710291393e-02f, 1.591549441e-02f, 1.481051371e-02f, 1.378225069e-02f, 1.282537635e-02f, 1.193493698e-02f, 1.110631879e-02f, 1.033522934e-02f, 9.617676027e-03f, 8.949940093e-03f, 8.328564465e-03f, 7.750329096e-03f, 7.212239318e-03f, 6.711508147e-03f, 6.245541852e-03f, 5.811926909e-03f, 5.408416502e-03f, 5.032921210e-03f, 4.683495965e-03f, 4.358330276e-03f, 4.055740312e-03f, 3.774158424e-03f, 3.512126394e-03f, 3.268286586e-03f, 3.041376127e-03f, 2.830219688e-03f, 2.633723198e-03f, 2.450869186e-03f, 2.280710265e-03f, 2.122365171e-03f, 1.975013874e-03f, 1.837892574e-03f, 1.710291486e-03f, 1.591549488e-03f, 1.481051440e-03f, 1.378225046e-03f, 1.282537705e-03f, 1.193493721e-03f, 1.110631856e-03f, 1.033523004e-03f, 9.617675678e-04f, 8.949940093e-04f, 8.328563999e-04f, 7.750329096e-04f, 7.212239434e-04f, 6.711508031e-04f, 6.245541736e-04f, 5.811926676e-04f, 5.408416619e-04f, 5.032921326e-04f, 4.683495790e-04f, 4.358330334e-04f, 4.055740137e-04f, 3.774158540e-04f, 3.512126277e-04f, 3.268286528e-04f, 3.041376185e-04f, 2.830219455e-04f, 2.633723198e-04f, 2.450869069e-04f, 2.280710323e-04f, 2.122365258e-04f, 1.975013729e-04f, 1.837892632e-04f, 1.710291544e-04f, 1.591549371e-04f, 1.481051440e-04f, 1.378224988e-04f, 1.282537705e-04f, 1.193493736e-04f, 1.110631856e-04f, 1.033522931e-04f, 9.617675823e-05f, 8.949940093e-05f, 8.328563854e-05f, 7.750328950e-05f, 7.212239143e-05f, 6.711508468e-05f, 6.245542318e-05f, 5.811926894e-05f, 5.408416473e-05f, 5.032921035e-05f, 4.683495717e-05f, 4.358330261e-05f, 4.055740283e-05f, 3.774158540e-05f, 3.512126204e-05f, 3.268286673e-05f, 3.041376112e-05f, 2.830219637e-05f, 2.633723125e-05f, 2.450869215e-05f, 2.280710396e-05f, 2.122365186e-05f, 1.975013765e-05f, 1.837892523e-05f, 1.710291508e-05f};
namespace pg8 {
#define PG8_LAS __attribute__((address_space(3)))
typedef unsigned short bf16_t;
typedef short bf16x8 __attribute__((ext_vector_type(8)));
typedef float f32x4 __attribute__((ext_vector_type(4)));
typedef unsigned u32x4 __attribute__((ext_vector_type(4)));
constexpr int BM = 256, BK = 64, HALF = 128, HTB = HALF * BK * 2  , STAGE_BYTES = 8 * HTB, NXCD = 8, WGM = 8;

__host__ __device__ __forceinline__ int lds_byte(int r, int c) { const int st = (r >> 4) * 2 + (c >> 5), rr = r & 15, cc = c & 31, ob = rr * 64 + cc * 2; return st * 1024 + (ob ^ (((ob >> 9) & 1) << 5)); }
__host__ __device__ __forceinline__ void stage_rc(int b, int& R, int& C) { const int st = b / 1024, sb = b % 1024, swz = sb ^ (((sb >> 9) & 1) << 5); R = (st >> 1) * 16 + swz / 64; C = (st & 1) * 32 + (swz % 64) / 2; }
__host__ __device__ __forceinline__ int perm32(int rho) { const int n = rho >> 4, i = rho & 15; return 8 * (i >> 2) + 4 * n + (i & 3); }

struct Unit { int pm, pn; };
struct Gemm { const bf16_t* A; const bf16_t* Bt; int M, N, K; };

struct StaticOrder {
    int nM, nN, nwg, G, c, skip_at, skip_by;
    __host__ __device__ void init(int M, int N, int G_, int c_) { nM = M / BM; nN = N / BM; nwg = nM * nN; G = G_; c = c_; skip_at = 1 << 30; skip_by = 0; }
    __host__ __device__ bool next(int i, Unit& u) const {
        const long L = (long)i * G + c; if (L >= nwg) return false;
        int wgid = (int)L; { const int q = nwg / NXCD, r = nwg % NXCD, xcd = wgid % NXCD, off = wgid / NXCD; wgid = (xcd < r ? xcd * (q + 1) : r * (q + 1) + (xcd - r) * q) + off; }
        const int nig = WGM * nN, gid = wgid / nig, fm = gid * WGM, gsz = (nM - fm) < WGM ? (nM - fm) : WGM;
        u.pm = fm + ((wgid % nig) % gsz); u.pn = (wgid % nig) / gsz; if (u.pm >= skip_at) u.pm += skip_by; return true;
    }
    __device__ __forceinline__ void a_ready(const Unit&) const {}
    __device__ __forceinline__ void done(const Unit&) const {}
};
typedef float f32x2_cv __attribute__((ext_vector_type(2))); typedef __bf16 bf16x2_cv __attribute__((ext_vector_type(2)));
__device__ __forceinline__ unsigned cvt_pk_bf16(float lo, float hi) { const f32x2_cv v = {lo, hi}; return __builtin_bit_cast(unsigned, __builtin_convertvector(v, bf16x2_cv)); }
__device__ __forceinline__ float bflo(unsigned w) { return __uint_as_float(w << 16); }
__device__ __forceinline__ float bfhi(unsigned w) { return __uint_as_float(w & 0xffff0000u); }
__device__ __forceinline__ float sigm(float x) { return __builtin_amdgcn_rcpf(1.f + __expf(-x)); }
__device__ __forceinline__ void unpack8(const u32x4 w, float (&f)[8]) {
    f[0] = bflo(w.x); f[1] = bfhi(w.x); f[2] = bflo(w.y); f[3] = bfhi(w.y); f[4] = bflo(w.z); f[5] = bfhi(w.z); f[6] = bflo(w.w); f[7] = bfhi(w.w); }
__device__ __forceinline__ u32x4 pack8(const float (&f)[8]) {
    u32x4 w; w.x = cvt_pk_bf16(f[0], f[1]); w.y = cvt_pk_bf16(f[2], f[3]); w.z = cvt_pk_bf16(f[4], f[5]); w.w = cvt_pk_bf16(f[6], f[7]); return w; }

struct EpiF32 {
    static constexpr bool PERM = false, AFTER_DRAIN = false;
    float* C; int ldc;
    __device__ __forceinline__ void operator()(const f32x4 (&acc)[2][2][4][2], const Unit& u, int wr, int wc, int fr, int fq) const {
        asm volatile("" : "+v"(fr), "+v"(fq));
        const int row0 = u.pm * BM + wr * 64 + fr, col0 = u.pn * BM + wc * 32 + 4 * fq;
#pragma unroll
        for (int ai = 0; ai < 2; ++ai)
#pragma unroll
            for (int m = 0; m < 4; ++m) { float* rowp = C + (size_t)(row0 + ai * HALF + m * 16) * ldc + col0;
#pragma unroll
                for (int bj = 0; bj < 2; ++bj)
#pragma unroll
                    for (int n = 0; n < 2; ++n) *(f32x4*)(rowp + bj * HALF + n * 16) = acc[ai][bj][m][n]; }
    }
};

struct EpiBf {
    static constexpr bool PERM = true, AFTER_DRAIN = false;
    int mode; bf16_t *o0, *o1, *o2; const bf16_t *a1, *a2; int ldo, ld1, ld2, seqmask;
    __device__ __forceinline__ void operator()(const f32x4 (&acc)[2][2][4][2], const Unit& u, int wr, int wc, int fr, int fq) const {
        asm volatile("" : "+v"(fr), "+v"(fq));
        const int row0 = u.pm * BM + wr * 64 + fr, cin = wc * 32 + 8 * fq;
        if (mode == 1) {
            bf16_t* base = (u.pn < 4) ? o0 : o1; const float sc = (u.pn < 4) ? 1.f : 0.0625f; const int h = u.pn & 3;
            float it[8];
#pragma unroll
            for (int e = 0; e < 8; ++e) it[e] = INVT[cin + e];
            const int s1 = cin >> 4, hb = (cin >> 3) & 1;
#pragma unroll
            for (int ai = 0; ai < 2; ++ai)
#pragma unroll
                for (int m = 0; m < 4; ++m) { const int row = row0 + ai * HALF + m * 16; const float pos = (float)(row & seqmask);
                    float r1[8], r2[8];
#pragma unroll
                    for (int e = 0; e < 8; ++e) { const float x1 = acc[ai][0][m][e >> 2][e & 3], x2 = acc[ai][1][m][e >> 2][e & 3];
                        const float f = __builtin_amdgcn_fractf(pos * it[e]); const float s = __builtin_amdgcn_sinf(f), c = __builtin_amdgcn_cosf(f);
                        r1[e] = (x1 * c - x2 * s) * sc; r2[e] = (x1 * s + x2 * c) * sc; }
                    bf16_t* p = base + ((((size_t)(h * 512 + (row >> 5)) * 16 + s1) * 64 + hb * 32 + (row & 31)) << 3);
                    *(u32x4*)p = pack8(r1); *(u32x4*)(p + 8 * 64 * 8) = pack8(r2); }
            return;
        }
        if (mode == 7) {
            const int t0 = u.pn * BM + cin;
            if (u.pm < 4) {
#pragma unroll
                for (int ai = 0; ai < 2; ++ai)
#pragma unroll
                    for (int m = 0; m < 4; ++m) { const int wrow = u.pm * 256 + ai * HALF + wr * 64 + m * 16 + fr, hd = wrow >> 6, dh = wrow & 63;
#pragma unroll
                        for (int bj = 0; bj < 2; ++bj) { const int t = t0 + bj * HALF; float r[8];
#pragma unroll
                            for (int e = 0; e < 8; ++e) r[e] = acc[ai][bj][m][e >> 2][e & 3];
                            *(u32x4*)(o2 + ((((size_t)hd * 2048 + (t >> 3)) * 64 + dh) << 3)) = pack8(r); } }
            } else if (u.pm < 12) { const int h = u.pm - 8;
#pragma unroll
                for (int m = 0; m < 4; ++m) { const int i = wr * 64 + m * 16 + fr; const float itv = INVT[i];
#pragma unroll
                    for (int bj = 0; bj < 2; ++bj) { const int t = t0 + bj * HALF; float r1[8], r2[8];
#pragma unroll
                        for (int e = 0; e < 8; ++e) { const float x1 = acc[0][bj][m][e >> 2][e & 3], x2 = acc[1][bj][m][e >> 2][e & 3]; const float pos = (float)((t + e) & seqmask);
                            const float f = __builtin_amdgcn_fractf(pos * itv); const float s = __builtin_amdgcn_sinf(f), c = __builtin_amdgcn_cosf(f);
                            r1[e] = (x1 * c - x2 * s) * 0.0625f; r2[e] = (x1 * s + x2 * c) * 0.0625f; }
                        bf16_t* p = o0 + ((((((size_t)(h * 128 + (t >> 7)) * 8 + (i >> 5)) * 8 + ((t & 127) >> 4)) * 64) + ((t >> 3) & 1) * 32 + (i & 31)) << 3);
                        *(u32x4*)p = pack8(r1); *(u32x4*)(p + 4 * 8 * 64 * 8) = pack8(r2); } }
            } else {
#pragma unroll
                for (int ai = 0; ai < 2; ++ai)
#pragma unroll
                    for (int m = 0; m < 4; ++m) { const int dvg = (u.pm - 12) * 256 + ai * HALF + wr * 64 + m * 16 + fr, h = dvg >> 9, dv = dvg & 511;
#pragma unroll
                        for (int bj = 0; bj < 2; ++bj) { const int t = t0 + bj * HALF; float r[8];
#pragma unroll
                            for (int e = 0; e < 8; ++e) r[e] = acc[ai][bj][m][e >> 2][e & 3];
                            bf16_t* p = o1 + ((((((size_t)(h * 128 + (t >> 7)) * 16 + (dv >> 5)) * 8 + ((t & 127) >> 4)) * 64) + ((t >> 3) & 1) * 32 + (dv & 31)) << 3);
                            *(u32x4*)p = pack8(r); } }
            }
            return;
        }
        if (mode == 6) {
            const int ocol = u.pn * 128 + cin;
#pragma unroll
            for (int ai = 0; ai < 2; ++ai)
#pragma unroll
                for (int m = 0; m < 4; ++m) { const int row = row0 + ai * HALF + m * 16; float r[8];
#pragma unroll
                    for (int e = 0; e < 8; ++e) { const float a = acc[ai][0][m][e >> 2][e & 3], g = acc[ai][1][m][e >> 2][e & 3]; r[e] = a * sigm(a) * g; }
                    *(u32x4*)(o0 + (size_t)row * ldo + ocol) = pack8(r); }
            return;
        }
        bf16_t* ob = o0; int ocol = u.pn * BM + cin, ld = ldo; float sc = 1.f;
        if (mode == 0 && u.pn >= 4) {
#pragma unroll
            for (int ai = 0; ai < 2; ++ai)
#pragma unroll
                for (int m = 0; m < 4; ++m) { const int row = row0 + ai * HALF + m * 16;
#pragma unroll
                    for (int bj = 0; bj < 2; ++bj) { const int cc = bj * HALF + cin, h = (u.pn - 4) * 4 + (cc >> 6), dh0 = cc & 63; float r[8];
#pragma unroll
                        for (int e = 0; e < 8; ++e) r[e] = acc[ai][bj][m][e >> 2][e & 3];
                        *(u32x4*)(o1 + ((((((size_t)(h * 2 + (dh0 >> 5)) * 2048 + (row >> 3)) * 4 + ((dh0 >> 3) & 3)) * 8) + (row & 7)) << 3)) = pack8(r); } }
            return;
        }
        if (mode == 0) { sc = 0.125f; ld = 1024; }
#pragma unroll
        for (int ai = 0; ai < 2; ++ai)
#pragma unroll
            for (int m = 0; m < 4; ++m) { const int row = row0 + ai * HALF + m * 16;
#pragma unroll
                for (int bj = 0; bj < 2; ++bj) { const int col = ocol + bj * HALF; float r[8];
#pragma unroll
                    for (int e = 0; e < 8; ++e) r[e] = acc[ai][bj][m][e >> 2][e & 3];
                    if (mode == 0) {
#pragma unroll
                        for (int e = 0; e < 8; ++e) r[e] *= sc;
                    } else if (mode == 2) {
#pragma unroll
                        for (int e = 0; e < 8; ++e) r[e] = sigm(r[e]);
                    } else {
                        float x[8]; unpack8(*(const u32x4*)(a1 + (size_t)row * ld1 + col), x);
                        if (mode == 3) {
#pragma unroll
                            for (int e = 0; e < 8; ++e) r[e] = r[e] * sigm(r[e]) * x[e];
                        } else if (mode == 4) {
#pragma unroll
                            for (int e = 0; e < 8; ++e) r[e] = r[e] * x[e];
                        } else {
                            float y[8]; unpack8(*(const u32x4*)(a2 + (size_t)row * ld2 + col), y);
#pragma unroll
                            for (int e = 0; e < 8; ++e) r[e] = y[e] + r[e] * x[e];
                        }
                    }
                    *(u32x4*)(ob + (size_t)row * ld + col) = pack8(r); } }
    }
};

template <class Epi, class Sched, bool ALIGN_EPI = false, bool SP2 = false>
__device__ __forceinline__ void gemm_phase(PG8_LAS unsigned char* lds, const Gemm g, const Sched& S, const Epi& E) {
    int tid = threadIdx.x; asm volatile("" : "+v"(tid));
    const int wid = __builtin_amdgcn_readfirstlane(tid >> 6), lane = tid & 63, wr = wid >> 2, wc = wid & 3, fr = lane & 15, fq = lane >> 4;
    const int K = g.K, nt = K / BK;
    unsigned voffA[2], voffB[2];
#pragma unroll
    for (int i = 0; i < 2; ++i) { int R, C; stage_rc(tid * 16 + i * 8192, R, C); const int Rb = Epi::PERM ? ((R & ~31) + perm32(R & 31)) : R;
        voffA[i] = (unsigned)(R * K + C) * 2u; voffB[i] = (unsigned)(Rb * K + C) * 2u; }
    const size_t kstep = (size_t)(BK * 2);
    const size_t hstep = (size_t)HALF * K * 2;
    const size_t tstep = 2 * hstep;
    const unsigned ldsw = (unsigned)wid * 1024u;
    const int aoff = lds_byte(wr * 64 + fr, fq * 8), boff = lds_byte(wc * 32 + fr, fq * 8);
#define PG8_SA(b, h) (((b) * 2 + (h)) * HTB)
#define PG8_SB(b, h) ((4 + (b) * 2 + (h)) * HTB)
#define PG8_STAGE(bufoff, gbase, voff) do { _Pragma("unroll") for (int _i = 0; _i < 2; ++_i) \
        __builtin_amdgcn_global_load_lds((const unsigned*)((const char*)(gbase) + (voff)[_i]), (PG8_LAS unsigned*)(lds + (bufoff) + ldsw + _i * 8192), 16, 0, 0); } while (0)
#define PG8_LDA(dst, b, h) do { _Pragma("unroll") for (int m = 0; m < 4; ++m) _Pragma("unroll") for (int k = 0; k < 2; ++k) dst[m][k] = *(const PG8_LAS bf16x8*)(lds + PG8_SA(b, h) + aoff + m * 2048 + k * 1024); } while (0)
#define PG8_LDB(dst, b, h) do { _Pragma("unroll") for (int n = 0; n < 2; ++n) _Pragma("unroll") for (int k = 0; k < 2; ++k) dst[n][k] = *(const PG8_LAS bf16x8*)(lds + PG8_SB(b, h) + boff + n * 2048 + k * 1024); } while (0)
#define PG8_MMA(ai, bj, At, Bt) do { __builtin_amdgcn_s_setprio(1); _Pragma("unroll") for (int m = 0; m < 4; ++m) _Pragma("unroll") for (int n = 0; n < 2; ++n) _Pragma("unroll") for (int k = 0; k < 2; ++k) \
        acc[ai][bj][m][n] = __builtin_amdgcn_mfma_f32_16x16x32_bf16(Bt[n][k], At[m][k], acc[ai][bj][m][n], 0, 0, 0); __builtin_amdgcn_s_setprio(0); } while (0)
#define PG8_WAIT_V(n) asm volatile("s_waitcnt vmcnt(" #n ")" ::: "memory")
#define PG8_WAIT_L(n) asm volatile("s_waitcnt lgkmcnt(" #n ")" ::: "memory")
#define PG8_BAR __builtin_amdgcn_s_barrier()
#define PG8_SCHED __builtin_amdgcn_sched_barrier(0)
    Unit cur, nxt; int ui = 0;
    if (!S.next(0, cur)) return;
    f32x4 acc[2][2][4][2];
#pragma unroll
    for (int a = 0; a < 2; ++a)
#pragma unroll
        for (int b = 0; b < 2; ++b)
#pragma unroll
            for (int m = 0; m < 4; ++m)
#pragma unroll
                for (int n = 0; n < 2; ++n) acc[a][b][m][n] = (f32x4){0.f, 0.f, 0.f, 0.f};
    bf16x8 At[4][2], B0[2][2], B1[2][2];
    const char* cA = (const char*)g.A + (size_t)cur.pm * tstep; const char* cB = (const char*)g.Bt + (size_t)cur.pn * tstep;
    S.a_ready(cur);
    if constexpr (SP2) {
        PG8_STAGE(PG8_SB(0, 0), cB, voffB); PG8_STAGE(PG8_SB(0, 1), cB + hstep, voffB); PG8_STAGE(PG8_SA(0, 0), cA, voffA); PG8_STAGE(PG8_SA(0, 1), cA + hstep, voffA);
        if (wr == 1) PG8_BAR;
        PG8_WAIT_V(2); PG8_BAR;
        PG8_STAGE(PG8_SB(1, 0), cB + kstep, voffB); PG8_STAGE(PG8_SA(1, 0), cA + kstep, voffA); PG8_STAGE(PG8_SB(1, 1), cB + hstep + kstep, voffB);
        PG8_WAIT_V(6); PG8_BAR;
    } else {
        PG8_STAGE(PG8_SB(0, 0), cB, voffB); PG8_STAGE(PG8_SA(0, 0), cA, voffA); PG8_STAGE(PG8_SB(0, 1), cB + hstep, voffB); PG8_STAGE(PG8_SA(0, 1), cA + hstep, voffA);
        if (wr == 1) PG8_BAR;
        PG8_WAIT_V(4); PG8_BAR;
        PG8_STAGE(PG8_SB(1, 0), cB + kstep, voffB); PG8_STAGE(PG8_SA(1, 0), cA + kstep, voffA); PG8_STAGE(PG8_SB(1, 1), cB + hstep + kstep, voffB);
        PG8_WAIT_V(6); PG8_BAR;
    }
    for (;;) {
        const bool has_next = S.next(ui + 1, nxt);
        const char* nA = has_next ? (const char*)g.A + (size_t)nxt.pm * tstep : cA; const char* nB = has_next ? (const char*)g.Bt + (size_t)nxt.pn * tstep : cB;
        for (int t = 0; t < nt; t += 2) {
            const bool last = (t == nt - 2);
            const char* a1 = cA + (size_t)(t + 1) * kstep;
            const char* a2 = last ? nA : cA + (size_t)(t + 2) * kstep; const char* b2 = last ? nB : cB + (size_t)(t + 2) * kstep;
            const char* a3 = a2 + kstep; const char* b3 = b2 + kstep;
            if (last && has_next) S.a_ready(nxt);
            if constexpr (SP2) {
            PG8_LDB(B0, 0, 0); PG8_LDB(B1, 0, 1); PG8_SCHED; PG8_LDA(At, 0, 0); PG8_STAGE(PG8_SA(1, 1), a1 + hstep, voffA);
            PG8_WAIT_V(8); PG8_WAIT_L(0); PG8_BAR; PG8_MMA(0, 0, At, B0); PG8_MMA(0, 1, At, B1); PG8_BAR; PG8_SCHED;
            PG8_LDA(At, 0, 1); PG8_STAGE(PG8_SB(0, 0), b2, voffB); PG8_STAGE(PG8_SB(0, 1), b2 + hstep, voffB); PG8_STAGE(PG8_SA(0, 0), a2, voffA);
            PG8_WAIT_V(8); PG8_WAIT_L(0); PG8_BAR; PG8_MMA(1, 0, At, B0); PG8_MMA(1, 1, At, B1); PG8_BAR; PG8_SCHED;
            PG8_LDB(B0, 1, 0); PG8_LDB(B1, 1, 1); PG8_SCHED; PG8_LDA(At, 1, 0); PG8_STAGE(PG8_SA(0, 1), a2 + hstep, voffA);
            PG8_WAIT_V(8); PG8_WAIT_L(0); PG8_BAR; PG8_MMA(0, 0, At, B0); PG8_MMA(0, 1, At, B1); PG8_BAR; PG8_SCHED;
            PG8_LDA(At, 1, 1); PG8_STAGE(PG8_SB(1, 0), b3, voffB); PG8_STAGE(PG8_SB(1, 1), b3 + hstep, voffB); PG8_STAGE(PG8_SA(1, 0), a3, voffA);
            PG8_WAIT_V(8); PG8_WAIT_L(0); PG8_BAR; PG8_MMA(1, 0, At, B0); PG8_MMA(1, 1, At, B1); PG8_BAR; PG8_SCHED;
            } else {
            PG8_LDB(B0, 0, 0); PG8_SCHED; PG8_LDA(At, 0, 0); PG8_STAGE(PG8_SA(1, 1), a1 + hstep, voffA);
            PG8_WAIT_L(8); PG8_BAR; PG8_WAIT_L(0); PG8_MMA(0, 0, At, B0); PG8_BAR; PG8_SCHED;
            PG8_LDB(B1, 0, 1); PG8_STAGE(PG8_SB(0, 0), b2, voffB);
            PG8_BAR; PG8_WAIT_L(0); PG8_MMA(0, 1, At, B1); PG8_BAR;
            PG8_LDA(At, 0, 1); PG8_STAGE(PG8_SA(0, 0), a2, voffA);
            PG8_BAR; PG8_WAIT_L(0); PG8_MMA(1, 0, At, B0); PG8_BAR; PG8_SCHED;
            PG8_STAGE(PG8_SB(0, 1), b2 + hstep, voffB);
            PG8_WAIT_V(6); PG8_BAR; PG8_MMA(1, 1, At, B1); PG8_BAR;
            PG8_LDB(B0, 1, 0); PG8_SCHED; PG8_LDA(At, 1, 0); PG8_STAGE(PG8_SA(0, 1), a2 + hstep, voffA);
            PG8_WAIT_L(8); PG8_BAR; PG8_WAIT_L(0); PG8_MMA(0, 0, At, B0); PG8_BAR; PG8_SCHED;
            PG8_LDB(B1, 1, 1); PG8_STAGE(PG8_SB(1, 0), b3, voffB);
            PG8_BAR; PG8_WAIT_L(0); PG8_MMA(0, 1, At, B1); PG8_BAR;
            PG8_LDA(At, 1, 1); PG8_STAGE(PG8_SA(1, 0), a3, voffA);
            PG8_BAR; PG8_WAIT_L(0); PG8_MMA(1, 0, At, B0); PG8_BAR; PG8_SCHED;
            PG8_STAGE(PG8_SB(1, 1), b3 + hstep, voffB);
            PG8_WAIT_V(6); PG8_BAR; PG8_MMA(1, 1, At, B1); PG8_BAR;
            }
        }
        if constexpr (ALIGN_EPI) { if (wr == 0) PG8_BAR; }
        if constexpr (!Epi::AFTER_DRAIN) { E(acc, cur, wr, wc, fr, fq); S.done(cur); }
        if (!has_next) break;
#pragma unroll
        for (int a = 0; a < 2; ++a)
#pragma unroll
            for (int b = 0; b < 2; ++b)
#pragma unroll
                for (int m = 0; m < 4; ++m)
#pragma unroll
                    for (int n = 0; n < 2; ++n) acc[a][b][m][n] = (f32x4){0.f, 0.f, 0.f, 0.f};
        cur = nxt; cA = nA; cB = nB; ++ui;
        if constexpr (ALIGN_EPI) { if (wr == 1) PG8_BAR; }
    }
    PG8_WAIT_V(0);
    if constexpr (!ALIGN_EPI) { if (wr == 0) PG8_BAR; }
    PG8_BAR;
    if constexpr (Epi::AFTER_DRAIN) { E.fused(acc, cur, wr, wc, fr, fq, lds, wid, lane); S.done(cur); }
#undef PG8_SA
#undef PG8_SB
#undef PG8_STAGE
#undef PG8_LDA
#undef PG8_LDB
#undef PG8_MMA
#undef PG8_WAIT_V
#undef PG8_WAIT_L
#undef PG8_BAR
#undef PG8_SCHED
}
}
namespace cg = cooperative_groups;
#define LAS __attribute__((address_space(3)))
typedef unsigned short bf16;
typedef float f32x4 __attribute__((ext_vector_type(4)));
typedef unsigned u32x4 __attribute__((ext_vector_type(4)));
typedef unsigned u32x2 __attribute__((ext_vector_type(2)));

constexpr int NWAVES = 8, NTHREADS = 512;
constexpr int D = 1024, TP = 16384;
constexpr int FFN = 2816;
constexpr float EPS = 1e-6f;
enum { ST_H = 0, ST_G1N, ST_NA, ST_G1R, ST_R1, ST_R2, ST_HGN, ST_GATES, ST_G2, ST_G3, ST_G4, ST_N1, ST_G5, ST_G6, ST_N2, NSTEP };
constexpr int NPHASE = 2 + 2 * NSTEP;
constexpr int LDS_BYTES = 147456;
#ifndef DIS_MASK
#define DIS_MASK 0
#endif
constexpr unsigned DIS = DIS_MASK;

constexpr size_t MiB = 1u << 20;
constexpr size_t WS_CTL = 0, WS_MODP = 64 * 1024, WS_MOD = 704 * 1024;
constexpr size_t WS_WIN = 1 * MiB, WS_WNA = 23 * MiB, WS_WRET = 25 * MiB, WS_WOUT = 29 * MiB, WS_WFI = 31 * MiB, WS_WFO = 42 * MiB;
constexpr size_t WS_KT = 48 * MiB, WS_HB = 48 * MiB  , WS_MERGED = 48 * MiB, WS_F = 48 * MiB;
constexpr size_t WS_NQ = 80 * MiB, WS_H2 = 80 * MiB;
constexpr size_t WS_NK = 112 * MiB, WS_NV = 144 * MiB, WS_VT = 112 * MiB, WS_SG = 112 * MiB, WS_ACT = 112 * MiB;
constexpr size_t WS_HA = 176 * MiB  , WS_O = 176 * MiB, WS_OUTMIX = 176 * MiB, WS_END = 256 * MiB;

__device__ __forceinline__ float wave_sum(float v) {
#pragma unroll
    for (int o = 1; o < 64; o <<= 1) v += __shfl_xor(v, o);
    return v;
}
__device__ __forceinline__ float bf2f(unsigned short b) { return __uint_as_float((unsigned)b << 16); }
__device__ __forceinline__ unsigned pk2(float lo, float hi) { return pg8::cvt_pk_bf16(lo, hi); }
__device__ __forceinline__ float rdlane(float v, int l) { return __int_as_float(__builtin_amdgcn_readlane(__float_as_int(v), l)); }

__device__ __forceinline__ void transpose_item(const float* W, int K, int N, bf16* WT, int k0, int n0, int drow0, LAS float* scr, int lane) {
#pragma unroll 8
    for (int i = 0; i < 32; ++i) { const int kk = 2 * i + (lane >> 5); scr[kk * 33 + (lane & 31)] = W[(size_t)(k0 + kk) * N + n0 + (lane & 31)]; }
    asm volatile("s_waitcnt lgkmcnt(0)" ::: "memory");
    const int c = lane & 7;
#pragma unroll
    for (int j = 0; j < 4; ++j) { const int n = (lane >> 3) + 8 * j; const LAS float* s = scr + (8 * c) * 33 + n;
        u32x4 o; o.x = pk2(s[0 * 33], s[1 * 33]); o.y = pk2(s[2 * 33], s[3 * 33]); o.z = pk2(s[4 * 33], s[5 * 33]); o.w = pk2(s[6 * 33], s[7 * 33]);
        *(u32x4*)(WT + (size_t)(drow0 + n) * K + k0 + 8 * c) = o; }
    asm volatile("s_waitcnt lgkmcnt(0)" ::: "memory");
}

#define RLX_AGENT __ATOMIC_RELAXED, __HIP_MEMORY_SCOPE_AGENT
#define XB_TMO      128
#define XB_XCNT(j)  (256  + 64 * (j))
#define XB_XSUB(j)  (1280 + 64 * (j))
#define XB_XGEN(j)  (2304 + 64 * (j))
#define XB_TOP      3328
#define XB_TOPGEN   3392
#define XCD_BAR_WORDS 3456
#define XB_SPIN_CAP (1u << 18)

__device__ __forceinline__ unsigned xb_ld(unsigned* p)              { return __hip_atomic_load(p, __ATOMIC_RELAXED, __HIP_MEMORY_SCOPE_AGENT); }
__device__ __forceinline__ unsigned xb_add(unsigned* p, unsigned v) { return __hip_atomic_fetch_add(p, v, __ATOMIC_RELAXED, __HIP_MEMORY_SCOPE_AGENT); }
__device__ __forceinline__ unsigned xb_xcc_id() { return (unsigned)__builtin_amdgcn_s_getreg((3 << 11) | 20) & 0xFu; }
#define XB_SPIN(cond, bar) do { unsigned _sp = 0; while (cond) { __builtin_amdgcn_s_sleep(1); \
    if ((++_sp & 255u) == 0u) { if (xb_ld(&(bar)[XB_TMO])) break; if (_sp > XB_SPIN_CAP) { atomicAdd(&(bar)[XB_TMO], 1u); break; } } } } while (0)

struct XcdBarrier {
    unsigned* bar; unsigned x;
    volatile LAS unsigned* st;
};

__device__ __forceinline__ XcdBarrier xcd_barrier_post(unsigned* bar, volatile LAS unsigned* st) {
    XcdBarrier b; b.bar = bar; b.x = xb_xcc_id(); b.st = st;
    if (threadIdx.x == 0) (void)xb_add(&bar[XB_XCNT(b.x)], 1u);
    return b;
}
__device__ __forceinline__ void xcd_barrier_complete(unsigned* bar, unsigned x, unsigned& nloc, unsigned& nx) {
    const unsigned G = gridDim.x * gridDim.y * gridDim.z;
    unsigned sum, cnt, mine, sp = 0u;
    for (;;) {
        sum = 0u; cnt = 0u; mine = 0u;
#pragma unroll
        for (unsigned j = 0; j < 16; ++j) { const unsigned c = xb_ld(&bar[XB_XCNT(j)]); sum += c; cnt += (c > 0u) ? 1u : 0u; mine = (j == x) ? c : mine; }
        if (sum == G) break;
        __builtin_amdgcn_s_sleep(1);
        if ((++sp & 255u) == 0u) { if (xb_ld(&bar[XB_TMO])) break; if (sp > XB_SPIN_CAP) { atomicAdd(&bar[XB_TMO], 1u); break; } }
    }
    nloc = mine > 0u ? mine : 1u; nx = cnt > 0u ? cnt : 1u;
}

__device__ __forceinline__ void xcd_barrier(const XcdBarrier& b) {
    asm volatile("s_waitcnt vmcnt(0)" ::: "memory");
    __syncthreads();
    if (threadIdx.x == 0) {
        unsigned* bar = b.bar;
        __builtin_amdgcn_s_waitcnt(0);
        unsigned nloc = b.st[0], nx = b.st[1];
        if (nloc == 0u) { xcd_barrier_complete(bar, b.x, nloc, nx); b.st[0] = nloc; b.st[1] = nx; }
        const unsigned old = xb_add(&bar[XB_XSUB(b.x)], 1u);
        const unsigned gen = old / nloc;
        if (old + 1u == (gen + 1u) * nloc) {
            __builtin_amdgcn_fence(__ATOMIC_RELEASE, "agent");
            asm volatile("s_waitcnt vmcnt(0)" ::: "memory");
            const unsigned og = xb_add(&bar[XB_TOP], 1u);
            const unsigned tg = og / nx;
            if (og + 1u == (tg + 1u) * nx) xb_add(&bar[XB_TOPGEN], 1u);
            else XB_SPIN(xb_ld(&bar[XB_TOPGEN]) == tg, bar);
            __builtin_amdgcn_fence(__ATOMIC_ACQUIRE, "agent");
            xb_add(&bar[XB_XGEN(b.x)], 1u);
            asm volatile("s_waitcnt vmcnt(0)" ::: "memory");
        } else {
            XB_SPIN(xb_ld(&bar[XB_XGEN(b.x)]) == gen, bar);
            __builtin_amdgcn_fence(__ATOMIC_ACQUIRE, "agent");
            asm volatile("s_waitcnt vmcnt(0)" ::: "memory");
        }
    }
    __syncthreads();
}

constexpr int CW_BAR = 4096;
constexpr int RING_BYTES = 131072, MISC_OFF = RING_BYTES + 320;
constexpr size_t CTL_ZERO_BYTES = 64 * 1024;
#ifndef ONE_LAUNCH
#define ONE_LAUNCH 1
#endif
typedef float f32x16 __attribute__((ext_vector_type(16)));
typedef float f32x2 __attribute__((ext_vector_type(2)));
typedef short bf16x8 __attribute__((ext_vector_type(8)));
typedef short s16x2 __attribute__((ext_vector_type(2)));
typedef __bf16 bf16x2_t __attribute__((ext_vector_type(2)));
typedef unsigned long long u64x2 __attribute__((ext_vector_type(2)));
#define MFMA32(a, b, c) __builtin_amdgcn_mfma_f32_32x32x16_bf16((a), (b), (c), 0, 0, 0)
__device__ __forceinline__ void atomic_add_bf16x2(bf16* p, float a, float b) {
    f32x2 v = {a, b}; bf16x2_t w = __builtin_convertvector(v, bf16x2_t);
    __builtin_amdgcn_global_atomic_fadd_v2bf16((__attribute__((address_space(1))) s16x2*)p, __builtin_bit_cast(s16x2, w));
}
__device__ __forceinline__ float log2_sigmoid(float x) { return -log1pf(expf(-x)) * 1.4426950408889634f; }

__device__ __forceinline__ void h_rows(const float* xin, const float* MOD, const float* gain, bf16* Hout, int seq0, int seqlen, int gw, int NGW, int lane) {
    for (int t = gw; t < TP; t += NGW) { const float* mod = MOD + (size_t)(seq0 + t / seqlen) * 6144;
        const f32x4* xr = (const f32x4*)(xin + (size_t)t * D) + lane; f32x4 v[4]; float ss = 0.f;
#pragma unroll
        for (int j = 0; j < 4; ++j) { v[j] = xr[64 * j]; ss += (v[j].x * v[j].x + v[j].y * v[j].y) + (v[j].z * v[j].z + v[j].w * v[j].w); }
        const float rstd = 1.0f / sqrtf(wave_sum(ss) * (1.f / D) + EPS);
        u32x2* o8 = (u32x2*)(Hout + (size_t)t * D) + lane;
#pragma unroll
        for (int j = 0; j < 4; ++j) { const int c = 4 * lane + 256 * j; const f32x4 g = *(const f32x4*)(gain + c), sh = *(const f32x4*)(mod + c), sc = *(const f32x4*)(mod + 1024 + c);
            const f32x4 h = v[j] * rstd * g * (sc + 1.0f) + sh; u32x2 w; w.x = pk2(h.x, h.y); w.y = pk2(h.z, h.w); o8[64 * j] = w; }
    }
}

__device__ __forceinline__ void ret_intra(const bf16* QB, const bf16* KB, const bf16* VT, bf16* Ob, const float* decay_logit, int lane, int wave, int G) {
    const int r32 = lane & 31, hh = lane >> 5, qt = wave >> 1, dh = wave & 1, qi = 32 * qt + r32;
    for (int un = blockIdx.x; un < 512; un += G) { const int cg = un >> 2, h = un & 3;
        const float L2f = log2_sigmoid(decay_logit[h]), L2b = log2_sigmoid(decay_logit[4 + h]);
        f32x16 P[4];
#pragma unroll
        for (int kt = 0; kt < 4; ++kt)
#pragma unroll
            for (int g = 0; g < 16; ++g) P[kt][g] = 0.f;
        const bf16x8* qb = (const bf16x8*)QB + ((size_t)(h * 512 + cg * 4 + qt) * 16) * 64 + lane;
        const bf16x8* kb = (const bf16x8*)KB + ((size_t)(h * 512 + cg * 4) * 16) * 64 + lane;
#pragma unroll 4
        for (int s = 0; s < 16; ++s) { const bf16x8 bq = qb[s * 64];
#pragma unroll
            for (int kt = 0; kt < 4; ++kt) P[kt] = MFMA32(kb[(kt * 16 + s) * 64], bq, P[kt]); }
        bf16x8 pb[4][2];
#pragma unroll
        for (int kt = 0; kt < 4; ++kt) {
#pragma unroll
            for (int g = 0; g < 16; ++g) { const int kj = 32 * kt + (g & 3) + 8 * (g >> 2) + 4 * hh; const int d = qi - kj;
                P[kt][g] *= __builtin_amdgcn_exp2f(d >= 0 ? (float)d * L2f : (float)(-d) * L2b); }
#pragma unroll
            for (int s2 = 0; s2 < 2; ++s2) { u32x4 w; w.x = pk2(P[kt][8 * s2 + 0], P[kt][8 * s2 + 1]); w.y = pk2(P[kt][8 * s2 + 2], P[kt][8 * s2 + 3]);
                w.z = pk2(P[kt][8 * s2 + 4], P[kt][8 * s2 + 5]); w.w = pk2(P[kt][8 * s2 + 6], P[kt][8 * s2 + 7]); pb[kt][s2] = __builtin_bit_cast(bf16x8, w); }
        }
        const size_t tok = (size_t)cg * 128 + qi;
        for (int dvt = 0; dvt < 8; ++dvt) { const int dvtile = 8 * dh + dvt; f32x16 o;
#pragma unroll
            for (int g = 0; g < 16; ++g) o[g] = 0.f;
            const unsigned long long* vb = (const unsigned long long*)VT + (((size_t)(h * 128 + cg) * 16 + dvtile) * 8) * 128 + r32 * 2 + hh;
#pragma unroll
            for (int kt = 0; kt < 4; ++kt)
#pragma unroll
                for (int s2 = 0; s2 < 2; ++s2) { const int sb = 2 * kt + s2; u64x2 t2; t2.x = vb[sb * 128]; t2.y = vb[sb * 128 + 64];
                    o = MFMA32(__builtin_bit_cast(bf16x8, t2), pb[kt][s2], o); }
            bf16* op = Ob + tok * 2048 + 512 * h + 32 * dvtile + 4 * hh;
#pragma unroll
            for (int g4 = 0; g4 < 4; ++g4) { const unsigned long long w = (unsigned long long)pk2(o[4 * g4], o[4 * g4 + 1]) | ((unsigned long long)pk2(o[4 * g4 + 2], o[4 * g4 + 3]) << 32);
#ifdef R1_PLAIN_STORE
                *(unsigned long long*)(op + 8 * g4) = w; }
#else
                __hip_atomic_store((unsigned long long*)(op + 8 * g4), w, __ATOMIC_RELAXED, __HIP_MEMORY_SCOPE_AGENT); }
#endif
        }
    }
}

__device__ __forceinline__ void ret_scan(LAS unsigned char* lds, const bf16* QB, const bf16* KT, const bf16* VT, bf16* Ob, const float* decay_logit, int nseq, int seqlen, int tid, int lane, int wave, int G) {
    constexpr int ST_STRIDE = 528, ST_BYTES = 64 * ST_STRIDE, VL_OFF = 2 * ST_BYTES, ZT_OFF = VL_OFF + 2 * 16384;
    const int nc = seqlen >> 7, r32 = lane & 31, hh = lane >> 5, dt = wave & 1, tt = wave >> 1;
    const bf16x8* QBv = (const bf16x8*)QB; const bf16x8* KTv = (const bf16x8*)KT; const u32x4* VTv = (const u32x4*)VT;
    for (int item = blockIdx.x; item < nseq * 64; item += G) { const int sq = item >> 6, h = (item >> 4) & 3, dir = (item >> 3) & 1, sl = item & 7;
        const float L2 = log2_sigmoid(decay_logit[dir * 4 + h]); const float gC = __builtin_amdgcn_exp2f(128.f * L2);
        LAS float* ZT = (LAS float*)(lds + ZT_OFF);
        if (tid < 128) ZT[tid] = __builtin_amdgcn_exp2f(L2 * (dir == 0 ? (float)(127 - tid) : (float)tid));
        for (int i = tid; i < ST_BYTES / 16; i += NTHREADS) ((LAS u32x4*)lds)[i] = (u32x4){0u, 0u, 0u, 0u};
        const int qi = 32 * tt + r32; const float xi = __builtin_amdgcn_exp2f(L2 * (dir == 0 ? (float)(qi + 1) : (float)(128 - qi)));
        const int cbase = sq * nc;
        f32x16 S0, S1;
#pragma unroll
        for (int g = 0; g < 16; ++g) { S0[g] = 0.f; S1[g] = 0.f; }
        bf16x8 Qf[16], Kf[8]; u32x4 Vr[2];
        int cg = cbase + (dir == 0 ? 0 : nc - 1);
#pragma unroll
        for (int s = 0; s < 16; ++s) Qf[s] = QBv[((size_t)(h * 512 + cg * 4 + tt) * 16 + s) * 64 + lane];
#pragma unroll
        for (int s = 0; s < 8; ++s) Kf[s] = KTv[(((size_t)(h * 128 + cg) * 8 + wave) * 8 + s) * 64 + lane];
#pragma unroll
        for (int k = 0; k < 2; ++k) Vr[k] = VTv[((size_t)(h * 128 + cg) * 16 + 2 * sl) * 512 + tid + 512 * k];
        __syncthreads();
        for (int i = 0; i < nc; ++i) { const int buf = i & 1; const int in = (i + 1 < nc) ? i + 1 : i; const int cgn = cbase + (dir == 0 ? in : nc - 1 - in);
#pragma unroll
            for (int k = 0; k < 2; ++k) { const int u = tid + 512 * k, j0 = 16 * ((u >> 6) & 7) + 8 * ((u >> 5) & 1); float f[8]; pg8::unpack8(Vr[k], f);
                const f32x4 z0 = *(const LAS f32x4*)(ZT + j0), z1 = *(const LAS f32x4*)(ZT + j0 + 4);
                f[0] *= z0.x; f[1] *= z0.y; f[2] *= z0.z; f[3] *= z0.w; f[4] *= z1.x; f[5] *= z1.y; f[6] *= z1.z; f[7] *= z1.w;
                *(LAS u32x4*)(lds + VL_OFF + buf * 16384 + u * 16) = pg8::pack8(f); }
#pragma unroll
            for (int k = 0; k < 2; ++k) Vr[k] = VTv[((size_t)(h * 128 + cgn) * 16 + 2 * sl) * 512 + tid + 512 * k];
            __syncthreads();
            f32x16 cr;
#pragma unroll
            for (int g = 0; g < 16; ++g) cr[g] = 0.f;
            { const LAS unsigned char* stb = lds + buf * ST_BYTES + (32 * dt + r32) * ST_STRIDE + hh * 16;
#pragma unroll
              for (int s = 0; s < 16; ++s) cr = MFMA32(*(const LAS bf16x8*)(stb + s * 32), Qf[s], cr); }
#pragma unroll
            for (int s = 0; s < 16; ++s) Qf[s] = QBv[((size_t)(h * 512 + cgn * 4 + tt) * 16 + s) * 64 + lane];
            { bf16* op = Ob + ((size_t)cg * 128 + qi) * 2048 + 512 * h + 64 * sl + 32 * dt + 4 * hh;
#pragma unroll
              for (int g4 = 0; g4 < 4; ++g4) { atomic_add_bf16x2(op + 8 * g4, cr[4 * g4] * xi, cr[4 * g4 + 1] * xi); atomic_add_bf16x2(op + 8 * g4 + 2, cr[4 * g4 + 2] * xi, cr[4 * g4 + 3] * xi); } }
#pragma unroll
            for (int g = 0; g < 16; ++g) { S0[g] *= gC; S1[g] *= gC; }
            { const LAS unsigned char* vlb = lds + VL_OFF + buf * 16384 + lane * 16;
#pragma unroll
              for (int s = 0; s < 8; ++s) { S0 = MFMA32(Kf[s], *(const LAS bf16x8*)(vlb + s * 1024), S0); S1 = MFMA32(Kf[s], *(const LAS bf16x8*)(vlb + (8 + s) * 1024), S1); } }
#pragma unroll
            for (int s = 0; s < 8; ++s) Kf[s] = KTv[(((size_t)(h * 128 + cgn) * 8 + wave) * 8 + s) * 64 + lane];
            { LAS unsigned char* wb = lds + (buf ^ 1) * ST_BYTES + r32 * ST_STRIDE + 64 * wave + 8 * hh;
#pragma unroll
              for (int g4 = 0; g4 < 4; ++g4) { u32x2 w; w.x = pk2(S0[4 * g4], S0[4 * g4 + 1]); w.y = pk2(S0[4 * g4 + 2], S0[4 * g4 + 3]); *(LAS u32x2*)(wb + 16 * g4) = w;
                  w.x = pk2(S1[4 * g4], S1[4 * g4 + 1]); w.y = pk2(S1[4 * g4 + 2], S1[4 * g4 + 3]); *(LAS u32x2*)(wb + 32 * ST_STRIDE + 16 * g4) = w; } }
            cg = cgn;
        }
        __syncthreads();
    }
}

typedef float f32x4_ __attribute__((ext_vector_type(4)));
#define MFMA16(a, b, c) __builtin_amdgcn_mfma_f32_16x16x32_bf16((a), (b), (c), 0, 0, 0)
__device__ __forceinline__ void na_mfma(LAS unsigned char* lds, bf16* NQ, const bf16* NKB, const bf16* NVT, const float* rpb, int seqlen, int tid, int lane, int wave, int G) {
    LAS float* RP = (LAS float*)lds;
    for (int i = tid; i < 16 * 15 * 31; i += NTHREADS) RP[i] = rpb[i] * 1.4426950408889634f;
    __syncthreads();
    const int rows = seqlen >> 6, r16 = lane & 15, q4 = lane >> 4, g = wave & 3;
    const int c0 = (g == 0) ? 0 : ((g == 1) ? 8 : ((g == 2) ? 24 : 32)), c = 16 * g + r16;
    int cs = c - 8; cs = cs < 0 ? 0 : cs; cs = cs > 48 ? 48 : cs;
    constexpr int TB = TP / 8;
    for (int un = blockIdx.x; un < 256 * 8; un += G) { const int R = un >> 3, h = (un & 7) * 2 + (wave >> 2);
        const int r = R % rows, Rb = R - r; int rs = r - 4; rs = rs < 0 ? 0 : rs; rs = rs > rows - 8 ? rows - 8 : rs;
        const size_t tq = (size_t)R * 64 + c;
        bf16x8 qf[2];
#pragma unroll
        for (int ks = 0; ks < 2; ++ks) qf[ks] = *(const bf16x8*)(NQ + tq * 1024 + 64 * h + 32 * ks + 8 * q4);
        f32x4_ S[16];
#pragma unroll
        for (int kr = 0; kr < 8; ++kr) { const int tok0 = (Rb + rs + kr) * 64 + c0;
#pragma unroll
            for (int ch = 0; ch < 2; ++ch) { f32x4_ a = {0.f, 0.f, 0.f, 0.f};
#pragma unroll
                for (int ks = 0; ks < 2; ++ks) { const bf16x8 kf = *((const bf16x8*)NKB + ((size_t)(h * 2 + ks) * TB + ((tok0 + 16 * ch) >> 3) + (r16 >> 3)) * 32 + q4 * 8 + (r16 & 7));
                    a = MFMA16(kf, qf[ks], a); }
                S[2 * kr + ch] = a; } }
        float mx = -1e30f;
#pragma unroll
        for (int kr = 0; kr < 8; ++kr) { const LAS float* brow = RP + (h * 15 + (rs + kr - r + 7)) * 31 + 15 - c;
#pragma unroll
            for (int ch = 0; ch < 2; ++ch)
#pragma unroll
                for (int e = 0; e < 4; ++e) { const int kc = c0 + 16 * ch + 4 * q4 + e; const bool ok = (kc >= cs) && (kc < cs + 16);
                    const float s = ok ? S[2 * kr + ch][e] * 1.4426950408889634f + brow[ok ? kc : c] : -1e30f; S[2 * kr + ch][e] = s; mx = fmaxf(mx, s); } }
        mx = fmaxf(mx, __shfl_xor(mx, 16)); mx = fmaxf(mx, __shfl_xor(mx, 32));
        float l = 0.f;
#pragma unroll
        for (int t = 0; t < 16; ++t)
#pragma unroll
            for (int e = 0; e < 4; ++e) { const float p = __builtin_amdgcn_exp2f(S[t][e] - mx); S[t][e] = p; l += p; }
        l += __shfl_xor(l, 16); l += __shfl_xor(l, 32);
        const float il = 1.0f / l;
        f32x4_ O[4];
#pragma unroll
        for (int dt = 0; dt < 4; ++dt) O[dt] = (f32x4_){0.f, 0.f, 0.f, 0.f};
#pragma unroll
        for (int kr = 0; kr < 8; ++kr) { const int tok0 = (Rb + rs + kr) * 64 + c0;
            u32x4 w; w.x = pk2(S[2 * kr][0], S[2 * kr][1]); w.y = pk2(S[2 * kr][2], S[2 * kr][3]); w.z = pk2(S[2 * kr + 1][0], S[2 * kr + 1][1]); w.w = pk2(S[2 * kr + 1][2], S[2 * kr + 1][3]);
            const bf16x8 pf = __builtin_bit_cast(bf16x8, w);
            const int ta = tok0 + 4 * q4, tb = ta + 16;
#pragma unroll
            for (int dt = 0; dt < 4; ++dt) { u64x2 v2;
                v2.x = *((const unsigned long long*)NVT + (((size_t)h * TB + (ta >> 3)) * 64 + 16 * dt + r16) * 2 + ((ta >> 2) & 1));
                v2.y = *((const unsigned long long*)NVT + (((size_t)h * TB + (tb >> 3)) * 64 + 16 * dt + r16) * 2 + ((tb >> 2) & 1));
                O[dt] = MFMA16(__builtin_bit_cast(bf16x8, v2), pf, O[dt]); } }
#pragma unroll
        for (int dt = 0; dt < 4; ++dt) { u32x2 w; w.x = pk2(O[dt][0] * il, O[dt][1] * il); w.y = pk2(O[dt][2] * il, O[dt][3] * il);
            *(u32x2*)(NQ + tq * 1024 + 64 * h + 16 * dt + 4 * q4) = w; }
    }
    __syncthreads();
}

struct Args { const float* in[19]; float* out; unsigned char* ws; int ph_lo, ph_hi; };

__global__ void __launch_bounds__(NTHREADS, 2) fwd(Args args) {
    extern __shared__ __attribute__((aligned(16))) unsigned char lds_raw[];
    LAS unsigned char* lds = (LAS unsigned char*)lds_raw;
    for (int u = threadIdx.x; u < (LDS_BYTES - RING_BYTES) / 4; u += NTHREADS) ((LAS unsigned*)(lds + RING_BYTES))[u] = 0u;
    __syncthreads();
    if (args.ph_hi - args.ph_lo > 1) (void)xcd_barrier_post((unsigned*)(args.ws + WS_CTL) + CW_BAR, (volatile LAS unsigned*)(lds + MISC_OFF) + 8);
    for (int ph = args.ph_lo; ph < args.ph_hi; ++ph) {
    int tid = threadIdx.x; asm volatile("" : "+v"(tid));
    const int lane = tid & 63, wave = __builtin_amdgcn_readfirstlane(tid >> 6);
    const int G = gridDim.x, gw = blockIdx.x * NWAVES + wave, NGW = G * NWAVES;
    size_t zoff = 0; asm volatile("" : "+s"(zoff)); unsigned char* ws = args.ws + zoff;
    const float* x_prompt = args.in[0]; const float* x_sample = args.in[1]; const float* c_prompt = args.in[2]; const float* c_sample = args.in[3];
    const float* w_mod = args.in[4]; const float* b_mod = args.in[5]; const float* g_pre_mix = args.in[6]; const float* w_in = args.in[7];
    const float* rpb = args.in[8]; const float* decay_logit = args.in[9]; const float* ret_gn = args.in[10]; const float* w_up_na = args.in[11];
    const float* w_up_ret = args.in[12]; const float* w_out = args.in[13]; const float* g_post_mix = args.in[14]; const float* g_pre_ffn = args.in[15];
    const float* w_ffn_in = args.in[16]; const float* w_ffn_out = args.in[17]; const float* g_post_ffn = args.in[18];
    float* MODP = (float*)(ws + WS_MODP); float* MOD = (float*)(ws + WS_MOD);
    bf16* WIN = (bf16*)(ws + WS_WIN); bf16* WNA = (bf16*)(ws + WS_WNA); bf16* WRET = (bf16*)(ws + WS_WRET); bf16* WOUT = (bf16*)(ws + WS_WOUT);
    bf16* WFI = (bf16*)(ws + WS_WFI); bf16* WFO = (bf16*)(ws + WS_WFO);
    bf16* HA = (bf16*)(ws + WS_HA); bf16* HB = (bf16*)(ws + WS_HB); bf16* NQ = (bf16*)(ws + WS_NQ); bf16* NK = (bf16*)(ws + WS_NK); bf16* NV = (bf16*)(ws + WS_NV);
    bf16* KT = (bf16*)(ws + WS_KT); bf16* VT = (bf16*)(ws + WS_VT);
    bf16* Ob = (bf16*)(ws + WS_O); bf16* SG = (bf16*)(ws + WS_SG); bf16* MERGED = (bf16*)(ws + WS_MERGED);
    float* OUTMIX = (float*)(ws + WS_OUTMIX); bf16* H2 = (bf16*)(ws + WS_H2); bf16* ACT = (bf16*)(ws + WS_ACT); float* Fb = (float*)(ws + WS_F);
        if (ph == 0 && !(DIS & 1)) {
            LAS float* scr = (LAS float*)(lds + wave * 16384);
            constexpr int I_IN = 16 * 352, I_NA = 16 * 32, I_RET = 32 * 32, I_OUT = 16 * 32, I_FI = 16 * 176, I_FO = 44 * 32, I_MOD = 96 * 8;
            constexpr int NITEMS = I_IN + I_NA + I_RET + I_OUT + I_FI + I_FO + I_MOD;
            for (int it = gw; it < NITEMS; it += NGW) {
                int r = it;
                if (r < I_IN) { const int nb = r % 352, kb = r / 352; transpose_item(w_in, 1024, 11264, WIN, 64 * kb, 32 * nb, 32 * nb, scr, lane); continue; } r -= I_IN;
                if (r < I_NA) { const int nb = r % 32, kb = r / 32; transpose_item(w_up_na, 1024, 1024, WNA, 64 * kb, 32 * nb, 32 * nb, scr, lane); continue; } r -= I_NA;
                if (r < I_RET) { const int nb = r % 32, kb = r / 32; transpose_item(w_up_ret, 2048, 1024, WRET, 64 * kb, 32 * nb, 32 * nb, scr, lane); continue; } r -= I_RET;
                if (r < I_OUT) { const int nb = r % 32, kb = r / 32; transpose_item(w_out, 1024, 1024, WOUT, 64 * kb, 32 * nb, 32 * nb, scr, lane); continue; } r -= I_OUT;
                if (r < I_FI) { const int nb = r % 176, kb = r / 176; const int n0 = 32 * nb; const int j = (n0 < FFN) ? n0 : n0 - FFN;
                    const int drow = 256 * (j / 128) + (j % 128) + ((n0 < FFN) ? 0 : 128);
                    transpose_item(w_ffn_in, 1024, 2 * FFN, WFI, 64 * kb, n0, drow, scr, lane); continue; } r -= I_FI;
                if (r < I_FO) { const int nb = r % 32, kb = r / 32; transpose_item(w_ffn_out, FFN, 1024, WFO, 64 * kb, 32 * nb, 32 * nb, scr, lane); continue; } r -= I_FO;
                { const int strip = r % 96, kc = r / 96; const int j = strip * 64 + lane; float a0 = 0.f, a1 = 0.f, a2 = 0.f;
                    for (int k = kc * 128; k < kc * 128 + 128; ++k) { const float w = w_mod[(size_t)k * 6144 + j];
                        const float c0 = c_prompt[k], c1 = c_prompt[1024 + k], c2 = c_sample[k];
                        a0 += c0 * pg8::sigm(c0) * w; a1 += c1 * pg8::sigm(c1) * w; a2 += c2 * pg8::sigm(c2) * w; }
                    MODP[(kc * 3 + 0) * 6144 + j] = a0; MODP[(kc * 3 + 1) * 6144 + j] = a1; MODP[(kc * 3 + 2) * 6144 + j] = a2; }
            }
        } else if (ph == 1 && !(DIS & 2)) {
            for (int i = blockIdx.x * NTHREADS + tid; i < 3 * 6144; i += G * NTHREADS) { float s = b_mod[i % 6144];
#pragma unroll
                for (int kc = 0; kc < 8; ++kc) s += MODP[kc * 3 * 6144 + i];
                MOD[i] = s; }
        } else if (ph >= 2) {
            const int pass = (ph - 2) / NSTEP, step = (ph - 2) % NSTEP;
            const float* xin = pass == 0 ? x_sample : x_prompt; float* outp = args.out + (pass == 0 ? (size_t)TP * D : 0);
            const int seqlen = pass == 0 ? 16384 : 8192, seq0 = pass == 0 ? 2 : 0, nseq = pass == 0 ? 1 : 2;
            bf16* QB = (bf16*)outp; bf16* KB = QB + (size_t)TP * 1024; bf16* TNA = QB; bf16* NKB = QB; bf16* NVT = KB;
            if ((step == ST_H || step == ST_HGN) && !(DIS & 4)) {
                h_rows(xin, MOD, g_pre_mix, step == ST_H ? HA : HB, seq0, seqlen, gw, NGW, lane);
                if (step == ST_HGN) {
                    for (int t = gw; t < TP; t += NGW) {
#pragma unroll
                        for (int h = 0; h < 4; ++h) { bf16* p = Ob + (size_t)t * 2048 + 512 * h + 8 * lane; float f[8]; pg8::unpack8(*(const u32x4*)p, f);
                            float s = 0.f;
#pragma unroll
                            for (int e = 0; e < 8; ++e) s += f[e];
                            const float mu = wave_sum(s) * (1.f / 512.f); float q = 0.f;
#pragma unroll
                            for (int e = 0; e < 8; ++e) { f[e] -= mu; q += f[e] * f[e]; }
                            const float rstd = 1.0f / sqrtf(wave_sum(q) * (1.f / 512.f) + EPS);
                            const f32x4 g0 = *(const f32x4*)(ret_gn + 512 * h + 8 * lane), g1 = *(const f32x4*)(ret_gn + 512 * h + 8 * lane + 4);
                            f[0] *= rstd * g0.x; f[1] *= rstd * g0.y; f[2] *= rstd * g0.z; f[3] *= rstd * g0.w; f[4] *= rstd * g1.x; f[5] *= rstd * g1.y; f[6] *= rstd * g1.z; f[7] *= rstd * g1.w;
                            *(u32x4*)p = pg8::pack8(f); }
                    }
                }
            } else if ((step == ST_G1N || step == ST_G1R || step == ST_GATES || step == ST_G2 || step == ST_G3 || step == ST_G5) && !(DIS & 8)) {
                const int nparts = (step == ST_G1N || step == ST_GATES) ? 2 : 1;
                for (int part = 0; part < nparts; ++part) {
                    pg8::Gemm g; pg8::EpiBf E; E.o0 = nullptr; E.o1 = nullptr; E.o2 = nullptr; E.a1 = nullptr; E.a2 = nullptr; E.ldo = 1024; E.ld1 = 2048; E.ld2 = 1024; E.seqmask = seqlen - 1;
                    int skip_at = 1 << 30, skip_by = 0;
                    if (step == ST_G1N) {
                        if (part == 0)         { g = pg8::Gemm{HA, WIN, TP, 2048, 1024}; E.mode = 0; E.o0 = NQ; E.o1 = NKB; }
                        else                   { g = pg8::Gemm{WIN + (size_t)2048 * 1024, HA, 4096, TP, 1024}; E.mode = 7; E.o0 = KT; E.o1 = VT; E.o2 = NVT; skip_at = 4; skip_by = 4; }
                    } else if (step == ST_G1R) { g = pg8::Gemm{HA, WIN + (size_t)3072 * 1024, TP, 2048, 1024}; E.mode = 1; E.o0 = QB; E.o1 = KB;
                    } else if (step == ST_GATES) {
                        if (part == 0)         { g = pg8::Gemm{HB, WIN + (size_t)9216 * 1024, TP, 2048, 1024}; E.mode = 2; E.o0 = SG; E.ldo = 2048; }
                        else                   { g = pg8::Gemm{HB, WIN + (size_t)7168 * 1024, TP, 2048, 1024}; E.mode = 3; E.o0 = Ob; E.ldo = 2048; E.a1 = Ob; E.ld1 = 2048; }
                    }
                    else if (step == ST_G2)    { g = pg8::Gemm{NQ, WNA, TP, 1024, 1024}; E.mode = 4; E.o0 = TNA; E.ldo = 1024; E.a1 = SG; E.ld1 = 2048; }
                    else if (step == ST_G3)    { g = pg8::Gemm{Ob, WRET, TP, 1024, 2048}; E.mode = 5; E.o0 = MERGED; E.ldo = 1024; E.a1 = SG + 1024; E.ld1 = 2048; E.a2 = TNA; E.ld2 = 1024; }
                    else                       { g = pg8::Gemm{H2, WFI, TP, 2 * FFN, 1024}; E.mode = 6; E.o0 = ACT; E.ldo = FFN; }
                    pg8::StaticOrder S; S.init(g.M, g.N, G, (int)blockIdx.x); S.skip_at = skip_at; S.skip_by = skip_by;
                    pg8::gemm_phase<pg8::EpiBf, pg8::StaticOrder, true, true>(lds, g, S, E);
                    if (part + 1 < nparts) { asm volatile("s_waitcnt vmcnt(0) lgkmcnt(0)" ::: "memory"); __syncthreads(); }
                }
            } else if ((step == ST_G4 || step == ST_G6) && !(DIS & 16)) {
                pg8::Gemm g; pg8::EpiF32 E;
                if (step == ST_G4) { g = pg8::Gemm{MERGED, WOUT, TP, 1024, 1024}; E.C = OUTMIX; E.ldc = 1024; }
                else               { g = pg8::Gemm{ACT, WFO, TP, 1024, FFN}; E.C = Fb; E.ldc = 1024; }
                pg8::StaticOrder S; S.init(g.M, g.N, G, (int)blockIdx.x);
                pg8::gemm_phase<pg8::EpiF32, pg8::StaticOrder, true, true>(lds, g, S, E);
            } else if (step == ST_NA && !(DIS & 32)) {
                na_mfma(lds, NQ, NKB, NVT, rpb, seqlen, tid, lane, wave, G);
            } else if (step == ST_R1 && !(DIS & 64)) {
#ifdef PROBE_COPY_O
                for (size_t i = (size_t)blockIdx.x * NTHREADS + tid; i < (size_t)TP * 2048 / 8; i += (size_t)G * NTHREADS) ((u32x4*)Ob)[i] = (i & 1) ? ((const u32x4*)QB)[i] : ((const u32x4*)VT)[i];
#elif defined(PROBE_ZERO_O)
                for (size_t i = (size_t)blockIdx.x * NTHREADS + tid; i < (size_t)TP * 2048 / 8; i += (size_t)G * NTHREADS) ((u32x4*)Ob)[i] = (u32x4){0u, 0u, 0u, 0u};
#else
                ret_intra(QB, KB, VT, Ob, decay_logit, lane, wave, G);
#endif
            } else if (step == ST_R2 && !(DIS & 512)) {
                ret_scan(lds, QB, KT, VT, Ob, decay_logit, nseq, seqlen, tid, lane, wave, G);
            } else if (step == ST_N1 && !(DIS & 128)) {
                for (int t = gw; t < TP; t += NGW) { const float* mod = MOD + (size_t)(seq0 + t / seqlen) * 6144;
                    const f32x4* orow = (const f32x4*)(OUTMIX + (size_t)t * D) + lane; const f32x4* xr = (const f32x4*)(xin + (size_t)t * D) + lane; f32x4 v[4]; float ss = 0.f;
#pragma unroll
                    for (int j = 0; j < 4; ++j) { v[j] = orow[64 * j]; ss += (v[j].x * v[j].x + v[j].y * v[j].y) + (v[j].z * v[j].z + v[j].w * v[j].w); }
                    const float rstd = 1.0f / sqrtf(wave_sum(ss) * (1.f / D) + EPS); float s2 = 0.f;
                    f32x4* o4 = (f32x4*)(outp + (size_t)t * D) + lane;
#pragma unroll
                    for (int j = 0; j < 4; ++j) { const int c = 4 * lane + 256 * j; const f32x4 g = *(const f32x4*)(g_post_mix + c), gt = *(const f32x4*)(mod + 2048 + c);
                        v[j] = xr[64 * j] + gt * (v[j] * rstd * g); o4[64 * j] = v[j]; s2 += (v[j].x * v[j].x + v[j].y * v[j].y) + (v[j].z * v[j].z + v[j].w * v[j].w); }
                    const float rstd2 = 1.0f / sqrtf(wave_sum(s2) * (1.f / D) + EPS);
                    u32x2* o8 = (u32x2*)(H2 + (size_t)t * D) + lane;
#pragma unroll
                    for (int j = 0; j < 4; ++j) { const int c = 4 * lane + 256 * j; const f32x4 g = *(const f32x4*)(g_pre_ffn + c), sh = *(const f32x4*)(mod + 3072 + c), sc = *(const f32x4*)(mod + 4096 + c);
                        const f32x4 h = v[j] * rstd2 * g * (sc + 1.0f) + sh; u32x2 w; w.x = pk2(h.x, h.y); w.y = pk2(h.z, h.w); o8[64 * j] = w; }
                }
            } else if (step == ST_N2 && !(DIS & 256)) {
                for (int t = gw; t < TP; t += NGW) { const float* mod = MOD + (size_t)(seq0 + t / seqlen) * 6144;
                    const f32x4* frow = (const f32x4*)(Fb + (size_t)t * D) + lane; f32x4* o4 = (f32x4*)(outp + (size_t)t * D) + lane; f32x4 v[4]; float ss = 0.f;
#pragma unroll
                    for (int j = 0; j < 4; ++j) { v[j] = frow[64 * j]; ss += (v[j].x * v[j].x + v[j].y * v[j].y) + (v[j].z * v[j].z + v[j].w * v[j].w); }
                    const float rstd = 1.0f / sqrtf(wave_sum(ss) * (1.f / D) + EPS);
#pragma unroll
                    for (int j = 0; j < 4; ++j) { const int c = 4 * lane + 256 * j; const f32x4 g = *(const f32x4*)(g_post_ffn + c), gt = *(const f32x4*)(mod + 5120 + c);
                        o4[64 * j] = o4[64 * j] + gt * (v[j] * rstd * g); }
                }
            }
        }
        if (ph + 1 < args.ph_hi) {
            if (ph == 0) cg::this_grid().sync();
            else { XcdBarrier bar; bar.bar = (unsigned*)(args.ws + WS_CTL) + CW_BAR; bar.x = xb_xcc_id(); bar.st = (volatile LAS unsigned*)(lds + MISC_OFF) + 8; xcd_barrier(bar); }
        }
    }
}

extern "C" void kernel_launch(void* const* d_in, const int* in_sizes, int n_in, void* d_out, int out_size, void* d_ws, size_t ws_size, hipStream_t stream) {
    static int grid = 0;
    if (grid == 0) {
        if (n_in != 19 || out_size != 2 * TP * D || ws_size < WS_END) { fprintf(stderr, "kernel_launch: unexpected shapes (n_in %d out %d ws %zu)\n", n_in, out_size, ws_size); grid = -1; return; }
        int dev = 0, cus = 0;
        if (hipGetDevice(&dev) != hipSuccess || hipDeviceGetAttribute(&cus, hipDeviceAttributeMultiprocessorCount, dev) != hipSuccess) { grid = -1; return; }
        if (hipFuncSetAttribute((const void*)fwd, hipFuncAttributeMaxDynamicSharedMemorySize, LDS_BYTES) != hipSuccess) { fprintf(stderr, "kernel_launch: hipFuncSetAttribute failed\n"); grid = -1; return; }
        grid = cus;
    }
    if (grid < 0) return;
    Args a{};
    for (int i = 0; i < 19; ++i) a.in[i] = (const float*)d_in[i];
    a.out = (float*)d_out; a.ws = (unsigned char*)d_ws;
#if ONE_LAUNCH
    if (hipMemsetAsync((char*)d_ws + WS_CTL, 0, CTL_ZERO_BYTES, stream) != hipSuccess) { fprintf(stderr, "kernel_launch: memset failed\n"); return; }
    a.ph_lo = 0; a.ph_hi = NPHASE;
    void* kargs[] = {&a};
    const hipError_t e = hipLaunchCooperativeKernel((const void*)fwd, dim3(grid), dim3(NTHREADS), kargs, LDS_BYTES, stream);
    if (e != hipSuccess) fprintf(stderr, "kernel_launch: cooperative launch failed: %s (grid %d)\n", hipGetErrorString(e), grid);
#else
    for (int ph = 0; ph < NPHASE; ++ph) { a.ph_lo = ph; a.ph_hi = ph + 1; hipLaunchKernelGGL(fwd, dim3(grid), dim3(NTHREADS), LDS_BYTES, stream, a); }
#endif
}
```

```cpp
#include <hip/hip_runtime.h>
#include <hip/hip_cooperative_groups.h>
#include <cstdio>
#include <cstdint>
__device__ const float INVT[128] = {1.591549367e-01f, 1.481051445e-01f, 1.378225088e-01f, 1.282537729e-01f, 1.193493679e-01f, 1.110631898e-01f, 1.033522934e-01f, 9.617675841e-02f, 8.949939907e-02f, 8.328563720e-02f, 7.750328630e-02f, 7.212239504e-02f, 6.711508334e-02f, 6.245541945e-02f, 5.811926723e-02f, 5.408416688e-02f, 5.032921210e-02f, 4.683495685e-02f, 4.358330369e-02f, 4.055740312e-02f, 3.774158657e-02f, 3.512126207e-02f, 3.268286586e-02f, 3.041376173e-02f, 2.830219641e-02f, 2.633723244e-02f, 2.450869232e-02f, 2.280710265e-02f, 2.122365311e-02f, 1.975013874e-02f, 1.837892644e-02f, 1.710291393e-02f, 1.591549441e-02f, 1.481051371e-02f, 1.378225069e-02f, 1.282537635e-02f, 1.193493698e-02f, 1.110631879e-02f, 1.033522934e-02f, 9.617676027e-03f, 8.949940093e-03f, 8.328564465e-03f, 7.750329096e-03f, 7.212239318e-03f, 6.711508147e-03f, 6.245541852e-03f, 5.811926909e-03f, 5.408416502e-03f, 5.032921210e-03f, 4.683495965e-03f, 4.358330276e-03f, 4.055740312e-03f, 3.774158424e-03f, 3.512126394e-03f, 3.268286586e-03f, 3.041376127e-03f, 2.830219688e-03f, 2.633723198e-03f, 2.450869186e-03f, 2.280710265e-03f, 2.122365171e-03f, 1.975013874e-03f, 1.837892574e-03f, 1.710291486e-03f, 1.591549488e-03f, 1.481051440e-03f, 1.378225046e-03f, 1.282537705e-03f, 1.193493721e-03f, 1.110631856e-03f, 1.033523004e-03f, 9.617675678e-04f, 8.949940093e-04f, 8.328563999e-04f, 7.750329096e-04f, 7.212239434e-04f, 6.711508031e-04f, 6.245541736e-04f, 5.811926676e-04f, 5.408416619e-04f, 5.032921326e-04f, 4.683495790e-04f, 4.358330334e-04f, 4.055740137e-04f, 3.774158540e-04f, 3.512126277e-04f, 3.268286528e-04f, 3.041376185e-04f, 2.830219455e-04f, 2.633723198e-04f, 2.450869069e-04f, 2.280710323e-04f, 2.122365258e-04f, 1.975013729e-04f, 1.837892632e-04f, 1.710291544e-04f, 1.591549371e-04f, 1.481051440e-04f, 1.378224988e-04f, 1.282537705e-04f, 1.193493736e-04f, 1.110631856e-04f, 1.033522931e-04f, 9.617675823e-05f, 8.949940093e-05f, 8.328563854e-05f, 7.750328950e-05f, 7.212239143e-05f, 6.711508468e-05f, 6.245542318e-05f, 5.811926894e-05f, 5.408416473e-05f, 5.032921035e-05f, 4.683495717e-05f, 4.358330261e-05f, 4.055740283e-05f, 3.774158540e-05f, 3.512126204e-05f, 3.268286673e-05f, 3.041376112e-05f, 2.830219637e-05f, 2.633723125e-05f, 2.450869215e-05f, 2.280710396e-05f, 2.122365186e-05f, 1.975013765e-05f, 1.837892523e-05f, 1.710291508e-05f};
namespace pg8 {
#define PG8_LAS __attribute__((address_space(3)))
typedef unsigned short bf16_t;
typedef short bf16x8 __attribute__((ext_vector_type(8)));
typedef float f32x4 __attribute__((ext_vector_type(4)));
typedef unsigned u32x4 __attribute__((ext_vector_type(4)));
constexpr int BM = 256, BK = 64, HALF = 128, HTB = HALF * BK * 2  , STAGE_BYTES = 8 * HTB, NXCD = 8, WGM = 8;

__host__ __device__ __forceinline__ int lds_byte(int r, int c) { const int st = (r >> 4) * 2 + (c >> 5), rr = r & 15, cc = c & 31, ob = rr * 64 + cc * 2; return st * 1024 + (ob ^ (((ob >> 9) & 1) << 5)); }
__host__ __device__ __forceinline__ void stage_rc(int b, int& R, int& C) { const int st = b / 1024, sb = b % 1024, swz = sb ^ (((sb >> 9) & 1) << 5); R = (st >> 1) * 16 + swz / 64; C = (st & 1) * 32 + (swz % 64) / 2; }
__host__ __device__ __forceinline__ int perm32(int rho) { const int n = rho >> 4, i = rho & 15; return 8 * (i >> 2) + 4 * n + (i & 3); }

struct Unit { int pm, pn; };
struct Gemm { const bf16_t* A; const bf16_t* Bt; int M, N, K; };

struct StaticOrder {
    int nM, nN, nwg, G, c, skip_at, skip_by;
    __host__ __device__ void init(int M, int N, int G_, int c_) { nM = M / BM; nN = N / BM; nwg = nM * nN; G = G_; c = c_; skip_at = 1 << 30; skip_by = 0; }
    __host__ __device__ bool next(int i, Unit& u) const {
        const long L = (long)i * G + c; if (L >= nwg) return false;
        int wgid = (int)L; { const int q = nwg / NXCD, r = nwg % NXCD, xcd = wgid % NXCD, off = wgid / NXCD; wgid = (xcd < r ? xcd * (q + 1) : r * (q + 1) + (xcd - r) * q) + off; }
        const int nig = WGM * nN, gid = wgid / nig, fm = gid * WGM, gsz = (nM - fm) < WGM ? (nM - fm) : WGM;
        u.pm = fm + ((wgid % nig) % gsz); u.pn = (wgid % nig) / gsz; if (u.pm >= skip_at) u.pm += skip_by; return true;
    }
    __device__ __forceinline__ void a_ready(const Unit&) const {}
    __device__ __forceinline__ void done(const Unit&) const {}
};
typedef float f32x2_cv __attribute__((ext_vector_type(2))); typedef __bf16 bf16x2_cv __attribute__((ext_vector_type(2)));
__device__ __forceinline__ unsigned cvt_pk_bf16(float lo, float hi) { const f32x2_cv v = {lo, hi}; return __builtin_bit_cast(unsigned, __builtin_convertvector(v, bf16x2_cv)); }
__device__ __forceinline__ float bflo(unsigned w) { return __uint_as_float(w << 16); }
__device__ __forceinline__ float bfhi(unsigned w) { return __uint_as_float(w & 0xffff0000u); }
__device__ __forceinline__ float sigm(float x) { return __builtin_amdgcn_rcpf(1.f + __expf(-x)); }
__device__ __forceinline__ void unpack8(const u32x4 w, float (&f)[8]) {
    f[0] = bflo(w.x); f[1] = bfhi(w.x); f[2] = bflo(w.y); f[3] = bfhi(w.y); f[4] = bflo(w.z); f[5] = bfhi(w.z); f[6] = bflo(w.w); f[7] = bfhi(w.w); }
__device__ __forceinline__ u32x4 pack8(const float (&f)[8]) {
    u32x4 w; w.x = cvt_pk_bf16(f[0], f[1]); w.y = cvt_pk_bf16(f[2], f[3]); w.z = cvt_pk_bf16(f[4], f[5]); w.w = cvt_pk_bf16(f[6], f[7]); return w; }

struct EpiF32 {
    static constexpr bool PERM = false, AFTER_DRAIN = false;
    float* C; int ldc;
    __device__ __forceinline__ void operator()(const f32x4 (&acc)[2][2][4][2], const Unit& u, int wr, int wc, int fr, int fq) const {
        asm volatile("" : "+v"(fr), "+v"(fq));
        const int row0 = u.pm * BM + wr * 64 + fr, col0 = u.pn * BM + wc * 32 + 4 * fq;
#pragma unroll
        for (int ai = 0; ai < 2; ++ai)
#pragma unroll
            for (int m = 0; m < 4; ++m) { float* rowp = C + (size_t)(row0 + ai * HALF + m * 16) * ldc + col0;
#pragma unroll
                for (int bj = 0; bj < 2; ++bj)
#pragma unroll
                    for (int n = 0; n < 2; ++n) *(f32x4*)(rowp + bj * HALF + n * 16) = acc[ai][bj][m][n]; }
    }
};

struct EpiBf {
    static constexpr bool PERM = true, AFTER_DRAIN = false;
    int mode; bf16_t *o0, *o1, *o2; const bf16_t *a1, *a2; int ldo, ld1, ld2, seqmask;
    __device__ __forceinline__ void operator()(const f32x4 (&acc)[2][2][4][2], const Unit& u, int wr, int wc, int fr, int fq) const {
        asm volatile("" : "+v"(fr), "+v"(fq));
        const int row0 = u.pm * BM + wr * 64 + fr, cin = wc * 32 + 8 * fq;
        if (mode == 1) {
            bf16_t* base = (u.pn < 4) ? o0 : o1; const float sc = (u.pn < 4) ? 1.f : 0.0625f; const int h = u.pn & 3;
            float it[8];
#pragma unroll
            for (int e = 0; e < 8; ++e) it[e] = INVT[cin + e];
            const int s1 = cin >> 4, hb = (cin >> 3) & 1;
#pragma unroll
            for (int ai = 0; ai < 2; ++ai)
#pragma unroll
                for (int m = 0; m < 4; ++m) { const int row = row0 + ai * HALF + m * 16; const float pos = (float)(row & seqmask);
                    float r1[8], r2[8];
#pragma unroll
                    for (int e = 0; e < 8; ++e) { const float x1 = acc[ai][0][m][e >> 2][e & 3], x2 = acc[ai][1][m][e >> 2][e & 3];
                        const float f = __builtin_amdgcn_fractf(pos * it[e]); const float s = __builtin_amdgcn_sinf(f), c = __builtin_amdgcn_cosf(f);
                        r1[e] = (x1 * c - x2 * s) * sc; r2[e] = (x1 * s + x2 * c) * sc; }
                    bf16_t* p = base + ((((size_t)(h * 512 + (row >> 5)) * 16 + s1) * 64 + hb * 32 + (row & 31)) << 3);
                    *(u32x4*)p = pack8(r1); *(u32x4*)(p + 8 * 64 * 8) = pack8(r2); }
            return;
        }
        if (mode == 7) {
            const int t0 = u.pn * BM + cin;
            if (u.pm < 4) {
#pragma unroll
                for (int ai = 0; ai < 2; ++ai)
#pragma unroll
                    for (int m = 0; m < 4; ++m) { const int wrow = u.pm * 256 + ai * HALF + wr * 64 + m * 16 + fr, hd = wrow >> 6, dh = wrow & 63;
#pragma unroll
                        for (int bj = 0; bj < 2; ++bj) { const int t = t0 + bj * HALF; float r[8];
#pragma unroll
                            for (int e = 0; e < 8; ++e) r[e] = acc[ai][bj][m][e >> 2][e & 3];
                            *(u32x4*)(o2 + ((((size_t)hd * 2048 + (t >> 3)) * 64 + dh) << 3)) = pack8(r); } }
            } else if (u.pm < 12) { const int h = u.pm - 8;
#pragma unroll
                for (int m = 0; m < 4; ++m) { const int i = wr * 64 + m * 16 + fr; const float itv = INVT[i];
#pragma unroll
                    for (int bj = 0; bj < 2; ++bj) { const int t = t0 + bj * HALF; float r1[8], r2[8];
#pragma unroll
                        for (int e = 0; e < 8; ++e) { const float x1 = acc[0][bj][m][e >> 2][e & 3], x2 = acc[1][bj][m][e >> 2][e & 3]; const float pos = (float)((t + e) & seqmask);
                            const float f = __builtin_amdgcn_fractf(pos * itv); const float s = __builtin_amdgcn_sinf(f), c = __builtin_amdgcn_cosf(f);
                            r1[e] = (x1 * c - x2 * s) * 0.0625f; r2[e] = (x1 * s + x2 * c) * 0.0625f; }
                        bf16_t* p = o0 + ((((((size_t)(h * 128 + (t >> 7)) * 8 + (i >> 5)) * 8 + ((t & 127) >> 4)) * 64) + ((t >> 3) & 1) * 32 + (i & 31)) << 3);
                        *(u32x4*)p = pack8(r1); *(u32x4*)(p + 4 * 8 * 64 * 8) = pack8(r2); } }
            } else {
#pragma unroll
                for (int ai = 0; ai < 2; ++ai)
#pragma unroll
                    for (int m = 0; m < 4; ++m) { const int dvg = (u.pm - 12) * 256 + ai * HALF + wr * 64 + m * 16 + fr, h = dvg >> 9, dv = dvg & 511;
#pragma unroll
                        for (int bj = 0; bj < 2; ++bj) { const int t = t0 + bj * HALF; float r[8];
#pragma unroll
                            for (int e = 0; e < 8; ++e) r[e] = acc[ai][bj][m][e >> 2][e & 3];
                            bf16_t* p = o1 + ((((((size_t)(h * 128 + (t >> 7)) * 16 + (dv >> 5)) * 8 + ((t & 127) >> 4)) * 64) + ((t >> 3) & 1) * 32 + (dv & 31)) << 3);
                            *(u32x4*)p = pack8(r); } }
            }
            return;
        }
        if (mode == 6) {
            const int ocol = u.pn * 128 + cin;
#pragma unroll
            for (int ai = 0; ai < 2; ++ai)
#pragma unroll
                for (int m = 0; m < 4; ++m) { const int row = row0 + ai * HALF + m * 16; float r[8];
#pragma unroll
                    for (int e = 0; e < 8; ++e) { const float a = acc[ai][0][m][e >> 2][e & 3], g = acc[ai][1][m][e >> 2][e & 3]; r[e] = a * sigm(a) * g; }
                    *(u32x4*)(o0 + (size_t)row * ldo + ocol) = pack8(r); }
            return;
        }
        bf16_t* ob = o0; int ocol = u.pn * BM + cin, ld = ldo; float sc = 1.f;
        if (mode == 0 && u.pn >= 4) {
#pragma unroll
            for (int ai = 0; ai < 2; ++ai)
#pragma unroll
                for (int m = 0; m < 4; ++m) { const int row = row0 + ai * HALF + m * 16;
#pragma unroll
                    for (int bj = 0; bj < 2; ++bj) { const int cc = bj * HALF + cin, h = (u.pn - 4) * 4 + (cc >> 6), dh0 = cc & 63; float r[8];
#pragma unroll
                        for (int e = 0; e < 8; ++e) r[e] = acc[ai][bj][m][e >> 2][e & 3];
                        *(u32x4*)(o1 + ((((((size_t)(h * 2 + (dh0 >> 5)) * 2048 + (row >> 3)) * 4 + ((dh0 >> 3) & 3)) * 8) + (row & 7)) << 3)) = pack8(r); } }
            return;
        }
        if (mode == 0) { sc = 0.125f; ld = 1024; }
#pragma unroll
        for (int ai = 0; ai < 2; ++ai)
#pragma unroll
            for (int m = 0; m < 4; ++m) { const int row = row0 + ai * HALF + m * 16;
#pragma unroll
                for (int bj = 0; bj < 2; ++bj) { const int col = ocol + bj * HALF; float r[8];
#pragma unroll
                    for (int e = 0; e < 8; ++e) r[e] = acc[ai][bj][m][e >> 2][e & 3];
                    if (mode == 0) {
#pragma unroll
                        for (int e = 0; e < 8; ++e) r[e] *= sc;
                    } else if (mode == 2) {
#pragma unroll
                        for (int e = 0; e < 8; ++e) r[e] = sigm(r[e]);
                    } else {
                        float x[8]; unpack8(*(const u32x4*)(a1 + (size_t)row * ld1 + col), x);
                        if (mode == 3) {
#pragma unroll
                            for (int e = 0; e < 8; ++e) r[e] = r[e] * sigm(r[e]) * x[e];
                        } else if (mode == 4) {
#pragma unroll
                            for (int e = 0; e < 8; ++e) r[e] = r[e] * x[e];
                        } else {
                            float y[8]; unpack8(*(const u32x4*)(a2 + (size_t)row * ld2 + col), y);
#pragma unroll
                            for (int e = 0; e < 8; ++e) r[e] = y[e] + r[e] * x[e];
                        }
                    }
                    *(u32x4*)(ob + (size_t)row * ld + col) = pack8(r); } }
    }
};

template <class Epi, class Sched, bool ALIGN_EPI = false, bool SP2 = false>
__device__ __forceinline__ void gemm_phase(PG8_LAS unsigned char* lds, const Gemm g, const Sched& S, const Epi& E) {
    int tid = threadIdx.x; asm volatile("" : "+v"(tid));
    const int wid = __builtin_amdgcn_readfirstlane(tid >> 6), lane = tid & 63, wr = wid >> 2, wc = wid & 3, fr = lane & 15, fq = lane >> 4;
    const int K = g.K, nt = K / BK;
    unsigned voffA[2], voffB[2];
#pragma unroll
    for (int i = 0; i < 2; ++i) { int R, C; stage_rc(tid * 16 + i * 8192, R, C); const int Rb = Epi::PERM ? ((R & ~31) + perm32(R & 31)) : R;
        voffA[i] = (unsigned)(R * K + C) * 2u; voffB[i] = (unsigned)(Rb * K + C) * 2u; }
    const size_t kstep = (size_t)(BK * 2);
    const size_t hstep = (size_t)HALF * K * 2;
    const size_t tstep = 2 * hstep;
    const unsigned ldsw = (unsigned)wid * 1024u;
    const int aoff = lds_byte(wr * 64 + fr, fq * 8), boff = lds_byte(wc * 32 + fr, fq * 8);
#define PG8_SA(b, h) (((b) * 2 + (h)) * HTB)
#define PG8_SB(b, h) ((4 + (b) * 2 + (h)) * HTB)
#define PG8_STAGE(bufoff, gbase, voff) do { _Pragma("unroll") for (int _i = 0; _i < 2; ++_i) \
        __builtin_amdgcn_global_load_lds((const unsigned*)((const char*)(gbase) + (voff)[_i]), (PG8_LAS unsigned*)(lds + (bufoff) + ldsw + _i * 8192), 16, 0, 0); } while (0)
#define PG8_LDA(dst, b, h) do { _Pragma("unroll") for (int m = 0; m < 4; ++m) _Pragma("unroll") for (int k = 0; k < 2; ++k) dst[m][k] = *(const PG8_LAS bf16x8*)(lds + PG8_SA(b, h) + aoff + m * 2048 + k * 1024); } while (0)
#define PG8_LDB(dst, b, h) do { _Pragma("unroll") for (int n = 0; n < 2; ++n) _Pragma("unroll") for (int k = 0; k < 2; ++k) dst[n][k] = *(const PG8_LAS bf16x8*)(lds + PG8_SB(b, h) + boff + n * 2048 + k * 1024); } while (0)
#define PG8_MMA(ai, bj, At, Bt) do { __builtin_amdgcn_s_setprio(1); _Pragma("unroll") for (int m = 0; m < 4; ++m) _Pragma("unroll") for (int n = 0; n < 2; ++n) _Pragma("unroll") for (int k = 0; k < 2; ++k) \
        acc[ai][bj][m][n] = __builtin_amdgcn_mfma_f32_16x16x32_bf16(Bt[n][k], At[m][k], acc[ai][bj][m][n], 0, 0, 0); __builtin_amdgcn_s_setprio(0); } while (0)
#define PG8_WAIT_V(n) asm volatile("s_waitcnt vmcnt(" #n ")" ::: "memory")
#define PG8_WAIT_L(n) asm volatile("s_waitcnt lgkmcnt(" #n ")" ::: "memory")
#define PG8_BAR __builtin_amdgcn_s_barrier()
#define PG8_SCHED __builtin_amdgcn_sched_barrier(0)
    Unit cur, nxt; int ui = 0;
    if (!S.next(0, cur)) return;
    f32x4 acc[2][2][4][2];
#pragma unroll
    for (int a = 0; a < 2; ++a)
#pragma unroll
        for (int b = 0; b < 2; ++b)
#pragma unroll
            for (int m = 0; m < 4; ++m)
#pragma unroll
                for (int n = 0; n < 2; ++n) acc[a][b][m][n] = (f32x4){0.f, 0.f, 0.f, 0.f};
    bf16x8 At[4][2], B0[2][2], B1[2][2];
    const char* cA = (const char*)g.A + (size_t)cur.pm * tstep; const char* cB = (const char*)g.Bt + (size_t)cur.pn * tstep;
    S.a_ready(cur);
    if constexpr (SP2) {
        PG8_STAGE(PG8_SB(0, 0), cB, voffB); PG8_STAGE(PG8_SB(0, 1), cB + hstep, voffB); PG8_STAGE(PG8_SA(0, 0), cA, voffA); PG8_STAGE(PG8_SA(0, 1), cA + hstep, voffA);
        if (wr == 1) PG8_BAR;
        PG8_WAIT_V(2); PG8_BAR;
        PG8_STAGE(PG8_SB(1, 0), cB + kstep, voffB); PG8_STAGE(PG8_SA(1, 0), cA + kstep, voffA); PG8_STAGE(PG8_SB(1, 1), cB + hstep + kstep, voffB);
        PG8_WAIT_V(6); PG8_BAR;
    } else {
        PG8_STAGE(PG8_SB(0, 0), cB, voffB); PG8_STAGE(PG8_SA(0, 0), cA, voffA); PG8_STAGE(PG8_SB(0, 1), cB + hstep, voffB); PG8_STAGE(PG8_SA(0, 1), cA + hstep, voffA);
        if (wr == 1) PG8_BAR;
        PG8_WAIT_V(4); PG8_BAR;
        PG8_STAGE(PG8_SB(1, 0), cB + kstep, voffB); PG8_STAGE(PG8_SA(1, 0), cA + kstep, voffA); PG8_STAGE(PG8_SB(1, 1), cB + hstep + kstep, voffB);
        PG8_WAIT_V(6); PG8_BAR;
    }
    for (;;) {
        const bool has_next = S.next(ui + 1, nxt);
        const char* nA = has_next ? (const char*)g.A + (size_t)nxt.pm * tstep : cA; const char* nB = has_next ? (const char*)g.Bt + (size_t)nxt.pn * tstep : cB;
        for (int t = 0; t < nt; t += 2) {
            const bool last = (t == nt - 2);
            const char* a1 = cA + (size_t)(t + 1) * kstep;
            const char* a2 = last ? nA : cA + (size_t)(t + 2) * kstep; const char* b2 = last ? nB : cB + (size_t)(t + 2) * kstep;
            const char* a3 = a2 + kstep; const char* b3 = b2 + kstep;
            if (last && has_next) S.a_ready(nxt);
            if constexpr (SP2) {
            PG8_LDB(B0, 0, 0); PG8_LDB(B1, 0, 1); PG8_SCHED; PG8_LDA(At, 0, 0); PG8_STAGE(PG8_SA(1, 1), a1 + hstep, voffA);
            PG8_WAIT_V(8); PG8_WAIT_L(0); PG8_BAR; PG8_MMA(0, 0, At, B0); PG8_MMA(0, 1, At, B1); PG8_BAR; PG8_SCHED;
            PG8_LDA(At, 0, 1); PG8_STAGE(PG8_SB(0, 0), b2, voffB); PG8_STAGE(PG8_SB(0, 1), b2 + hstep, voffB); PG8_STAGE(PG8_SA(0, 0), a2, voffA);
            PG8_WAIT_V(8); PG8_WAIT_L(0); PG8_BAR; PG8_MMA(1, 0, At, B0); PG8_MMA(1, 1, At, B1); PG8_BAR; PG8_SCHED;
            PG8_LDB(B0, 1, 0); PG8_LDB(B1, 1, 1); PG8_SCHED; PG8_LDA(At, 1, 0); PG8_STAGE(PG8_SA(0, 1), a2 + hstep, voffA);
            PG8_WAIT_V(8); PG8_WAIT_L(0); PG8_BAR; PG8_MMA(0, 0, At, B0); PG8_MMA(0, 1, At, B1); PG8_BAR; PG8_SCHED;
            PG8_LDA(At, 1, 1); PG8_STAGE(PG8_SB(1, 0), b3, voffB); PG8_STAGE(PG8_SB(1, 1), b3 + hstep, voffB); PG8_STAGE(PG8_SA(1, 0), a3, voffA);
            PG8_WAIT_V(8); PG8_WAIT_L(0); PG8_BAR; PG8_MMA(1, 0, At, B0); PG8_MMA(1, 1, At, B1); PG8_BAR; PG8_SCHED;
            } else {
            PG8_LDB(B0, 0, 0); PG8_SCHED; PG8_LDA(At, 0, 0); PG8_STAGE(PG8_SA(1, 1), a1 + hstep, voffA);
            PG8_WAIT_L(8); PG8_BAR; PG8_WAIT_L(0); PG8_MMA(0, 0, At, B0); PG8_BAR; PG8_SCHED;
            PG8_LDB(B1, 0, 1); PG8_STAGE(PG8_SB(0, 0), b2, voffB);
            PG8_BAR; PG8_WAIT_L(0); PG8_MMA(0, 1, At, B1); PG8_BAR;
            PG8_LDA(At, 0, 1); PG8_STAGE(PG8_SA(0, 0), a2, voffA);
            PG8_BAR; PG8_WAIT_L(0); PG8_MMA(1, 0, At, B0); PG8_BAR; PG8_SCHED;
            PG8_STAGE(PG8_SB(0, 1), b2 + hstep, voffB);
            PG8_WAIT_V(6); PG8_BAR; PG8_MMA(1, 1, At, B1); PG8_BAR;
            PG8_LDB(B0, 1, 0); PG8_SCHED; PG8_LDA(At, 1, 0); PG8_STAGE(PG8_SA(0, 1), a2 + hstep, voffA);
            PG8_WAIT_L(8); PG8_BAR; PG8_WAIT_L(0); PG8_MMA(0, 0, At, B0); PG8_BAR; PG8_SCHED;
            PG8_LDB(B1, 1, 1); PG8_STAGE(PG8_SB(1, 0), b3, voffB);
            PG8_BAR; PG8_WAIT_L(0); PG8_MMA(0, 1, At, B1); PG8_BAR;
            PG8_LDA(At, 1, 1); PG8_STAGE(PG8_SA(1, 0), a3, voffA);
            PG8_BAR; PG8_WAIT_L(0); PG8_MMA(1, 0, At, B0); PG8_BAR; PG8_SCHED;
            PG8_STAGE(PG8_SB(1, 1), b3 + hstep, voffB);
            PG8_WAIT_V(6); PG8_BAR; PG8_MMA(1, 1, At, B1); PG8_BAR;
            }
        }
        if constexpr (ALIGN_EPI) { if (wr == 0) PG8_BAR; }
        if constexpr (!Epi::AFTER_DRAIN) { E(acc, cur, wr, wc, fr, fq); S.done(cur); }
        if (!has_next) break;
#pragma unroll
        for (int a = 0; a < 2; ++a)
#pragma unroll
            for (int b = 0; b < 2; ++b)
#pragma unroll
                for (int m = 0; m < 4; ++m)
#pragma unroll
                    for (int n = 0; n < 2; ++n) acc[a][b][m][n] = (f32x4){0.f, 0.f, 0.f, 0.f};
        cur = nxt; cA = nA; cB = nB; ++ui;
        if constexpr (ALIGN_EPI) { if (wr == 1) PG8_BAR; }
    }
    PG8_WAIT_V(0);
    if constexpr (!ALIGN_EPI) { if (wr == 0) PG8_BAR; }
    PG8_BAR;
    if constexpr (Epi::AFTER_DRAIN) { E.fused(acc, cur, wr, wc, fr, fq, lds, wid, lane); S.done(cur); }
#undef PG8_SA
#undef PG8_SB
#undef PG8_STAGE
#undef PG8_LDA
#undef PG8_LDB
#undef PG8_MMA
#undef PG8_WAIT_V
#undef PG8_WAIT_L
#undef PG8_BAR
#undef PG8_SCHED
}
}
namespace cg = cooperative_groups;
#define LAS __attribute__((address_space(3)))
typedef unsigned short bf16;
typedef float f32x4 __attribute__((ext_vector_type(4)));
typedef unsigned u32x4 __attribute__((ext_vector_type(4)));
typedef unsigned u32x2 __attribute__((ext_vector_type(2)));

constexpr int NWAVES = 8, NTHREADS = 512;
constexpr int D = 1024, TP = 16384;
constexpr int FFN = 2816;
constexpr float EPS = 1e-6f;
enum { ST_H = 0, ST_G1N, ST_NA, ST_G1R, ST_R1, ST_R2, ST_HGN, ST_GATES, ST_G2, ST_G3, ST_G4, ST_N1, ST_G5, ST_G6, ST_N2, NSTEP };
constexpr int NPHASE = 2 + 2 * NSTEP;
constexpr int LDS_BYTES = 147456;
#ifndef DIS_MASK
#define DIS_MASK 0
#endif
constexpr unsigned DIS = DIS_MASK;

constexpr size_t MiB = 1u << 20;
constexpr size_t WS_CTL = 0, WS_MODP = 64 * 1024, WS_MOD = 704 * 1024;
constexpr size_t WS_WIN = 1 * MiB, WS_WNA = 23 * MiB, WS_WRET = 25 * MiB, WS_WOUT = 29 * MiB, WS_WFI = 31 * MiB, WS_WFO = 42 * MiB;
constexpr size_t WS_KT = 48 * MiB, WS_HB = 48 * MiB  , WS_MERGED = 48 * MiB, WS_F = 48 * MiB;
constexpr size_t WS_NQ = 80 * MiB, WS_H2 = 80 * MiB;
constexpr size_t WS_NK = 112 * MiB, WS_NV = 144 * MiB, WS_VT = 112 * MiB, WS_SG = 112 * MiB, WS_ACT = 112 * MiB;
constexpr size_t WS_HA = 176 * MiB  , WS_O = 176 * MiB, WS_OUTMIX = 176 * MiB, WS_END = 256 * MiB;

__device__ __forceinline__ float wave_sum(float v) {
#pragma unroll
    for (int o = 1; o < 64; o <<= 1) v += __shfl_xor(v, o);
    return v;
}
__device__ __forceinline__ float bf2f(unsigned short b) { return __uint_as_float((unsigned)b << 16); }
__device__ __forceinline__ unsigned pk2(float lo, float hi) { return pg8::cvt_pk_bf16(lo, hi); }
__device__ __forceinline__ float rdlane(float v, int l) { return __int_as_float(__builtin_amdgcn_readlane(__float_as_int(v), l)); }

__device__ __forceinline__ void transpose_item(const float* W, int K, int N, bf16* WT, int k0, int n0, int drow0, LAS float* scr, int lane) {
#pragma unroll 8
    for (int i = 0; i < 32; ++i) { const int kk = 2 * i + (lane >> 5); scr[kk * 33 + (lane & 31)] = W[(size_t)(k0 + kk) * N + n0 + (lane & 31)]; }
    asm volatile("s_waitcnt lgkmcnt(0)" ::: "memory");
    const int c = lane & 7;
#pragma unroll
    for (int j = 0; j < 4; ++j) { const int n = (lane >> 3) + 8 * j; const LAS float* s = scr + (8 * c) * 33 + n;
        u32x4 o; o.x = pk2(s[0 * 33], s[1 * 33]); o.y = pk2(s[2 * 33], s[3 * 33]); o.z = pk2(s[4 * 33], s[5 * 33]); o.w = pk2(s[6 * 33], s[7 * 33]);
        *(u32x4*)(WT + (size_t)(drow0 + n) * K + k0 + 8 * c) = o; }
    asm volatile("s_waitcnt lgkmcnt(0)" ::: "memory");
}

#define RLX_AGENT __ATOMIC_RELAXED, __HIP_MEMORY_SCOPE_AGENT
#define XB_TMO      128
#define XB_XCNT(j)  (256  + 64 * (j))
#define XB_XSUB(j)  (1280 + 64 * (j))
#define XB_XGEN(j)  (2304 + 64 * (j))
#define XB_TOP      3328
#define XB_TOPGEN   3392
#define XCD_BAR_WORDS 3456
#define XB_SPIN_CAP (1u << 18)

__device__ __forceinline__ unsigned xb_ld(unsigned* p)              { return __hip_atomic_load(p, __ATOMIC_RELAXED, __HIP_MEMORY_SCOPE_AGENT); }
__device__ __forceinline__ unsigned xb_add(unsigned* p, unsigned v) { return __hip_atomic_fetch_add(p, v, __ATOMIC_RELAXED, __HIP_MEMORY_SCOPE_AGENT); }
__device__ __forceinline__ unsigned xb_xcc_id() { return (unsigned)__builtin_amdgcn_s_getreg((3 << 11) | 20) & 0xFu; }
#define XB_SPIN(cond, bar) do { unsigned _sp = 0; while (cond) { __builtin_amdgcn_s_sleep(1); \
    if ((++_sp & 255u) == 0u) { if (xb_ld(&(bar)[XB_TMO])) break; if (_sp > XB_SPIN_CAP) { atomicAdd(&(bar)[XB_TMO], 1u); break; } } } } while (0)

struct XcdBarrier {
    unsigned* bar; unsigned x;
    volatile LAS unsigned* st;
};

__device__ __forceinline__ XcdBarrier xcd_barrier_post(unsigned* bar, volatile LAS unsigned* st) {
    XcdBarrier b; b.bar = bar; b.x = xb_xcc_id(); b.st = st;
    if (threadIdx.x == 0) (void)xb_add(&bar[XB_XCNT(b.x)], 1u);
    return b;
}
__device__ __forceinline__ void xcd_barrier_complete(unsigned* bar, unsigned x, unsigned& nloc, unsigned& nx) {
    const unsigned G = gridDim.x * gridDim.y * gridDim.z;
    unsigned sum, cnt, mine, sp = 0u;
    for (;;) {
        sum = 0u; cnt = 0u; mine = 0u;
#pragma unroll
        for (unsigned j = 0; j < 16; ++j) { const unsigned c = xb_ld(&bar[XB_XCNT(j)]); sum += c; cnt += (c > 0u) ? 1u : 0u; mine = (j == x) ? c : mine; }
        if (sum == G) break;
        __builtin_amdgcn_s_sleep(1);
        if ((++sp & 255u) == 0u) { if (xb_ld(&bar[XB_TMO])) break; if (sp > XB_SPIN_CAP) { atomicAdd(&bar[XB_TMO], 1u); break; } }
    }
    nloc = mine > 0u ? mine : 1u; nx = cnt > 0u ? cnt : 1u;
}

__device__ __forceinline__ void xcd_barrier(const XcdBarrier& b) {
    asm volatile("s_waitcnt vmcnt(0)" ::: "memory");
    __syncthreads();
    if (threadIdx.x == 0) {
        unsigned* bar = b.bar;
        __builtin_amdgcn_s_waitcnt(0);
        unsigned nloc = b.st[0], nx = b.st[1];
        if (nloc == 0u) { xcd_barrier_complete(bar, b.x, nloc, nx); b.st[0] = nloc; b.st[1] = nx; }
        const unsigned old = xb_add(&bar[XB_XSUB(b.x)], 1u);
        const unsigned gen = old / nloc;
        if (old + 1u == (gen + 1u) * nloc) {
            __builtin_amdgcn_fence(__ATOMIC_RELEASE, "agent");
            asm volatile("s_waitcnt vmcnt(0)" ::: "memory");
            const unsigned og = xb_add(&bar[XB_TOP], 1u);
            const unsigned tg = og / nx;
            if (og + 1u == (tg + 1u) * nx) xb_add(&bar[XB_TOPGEN], 1u);
            else XB_SPIN(xb_ld(&bar[XB_TOPGEN]) == tg, bar);
            __builtin_amdgcn_fence(__ATOMIC_ACQUIRE, "agent");
            xb_add(&bar[XB_XGEN(b.x)], 1u);
            asm volatile("s_waitcnt vmcnt(0)" ::: "memory");
        } else {
            XB_SPIN(xb_ld(&bar[XB_XGEN(b.x)]) == gen, bar);
            __builtin_amdgcn_fence(__ATOMIC_ACQUIRE, "agent");
            asm volatile("s_waitcnt vmcnt(0)" ::: "memory");
        }
    }
    __syncthreads();
}

constexpr int CW_BAR = 4096;
constexpr int RING_BYTES = 131072, MISC_OFF = RING_BYTES + 320;
constexpr size_t CTL_ZERO_BYTES = 64 * 1024;
#ifndef ONE_LAUNCH
#define ONE_LAUNCH 1
#endif
typedef float f32x16 __attribute__((ext_vector_type(16)));
typedef float f32x2 __attribute__((ext_vector_type(2)));
typedef short bf16x8 __attribute__((ext_vector_type(8)));
typedef short s16x2 __attribute__((ext_vector_type(2)));
typedef __bf16 bf16x2_t __attribute__((ext_vector_type(2)));
typedef unsigned long long u64x2 __attribute__((ext_vector_type(2)));
#define MFMA32(a, b, c) __builtin_amdgcn_mfma_f32_32x32x16_bf16((a), (b), (c), 0, 0, 0)
__device__ __forceinline__ void atomic_add_bf16x2(bf16* p, float a, float b) {
    f32x2 v = {a, b}; bf16x2_t w = __builtin_convertvector(v, bf16x2_t);
    __builtin_amdgcn_global_atomic_fadd_v2bf16((__attribute__((address_space(1))) s16x2*)p, __builtin_bit_cast(s16x2, w));
}
__device__ __forceinline__ float log2_sigmoid(float x) { return -log1pf(expf(-x)) * 1.4426950408889634f; }

__device__ __forceinline__ void h_rows(const float* xin, const float* MOD, const float* gain, bf16* Hout, int seq0, int seqlen, int gw, int NGW, int lane) {
    for (int t = gw; t < TP; t += NGW) { const float* mod = MOD + (size_t)(seq0 + t / seqlen) * 6144;
        const f32x4* xr = (const f32x4*)(xin + (size_t)t * D) + lane; f32x4 v[4]; float ss = 0.f;
#pragma unroll
        for (int j = 0; j < 4; ++j) { v[j] = xr[64 * j]; ss += (v[j].x * v[j].x + v[j].y * v[j].y) + (v[j].z * v[j].z + v[j].w * v[j].w); }
        const float rstd = 1.0f / sqrtf(wave_sum(ss) * (1.f / D) + EPS);
        u32x2* o8 = (u32x2*)(Hout + (size_t)t * D) + lane;
#pragma unroll
        for (int j = 0; j < 4; ++j) { const int c = 4 * lane + 256 * j; const f32x4 g = *(const f32x4*)(gain + c), sh = *(const f32x4*)(mod + c), sc = *(const f32x4*)(mod + 1024 + c);
            const f32x4 h = v[j] * rstd * g * (sc + 1.0f) + sh; u32x2 w; w.x = pk2(h.x, h.y); w.y = pk2(h.z, h.w); o8[64 * j] = w; }
    }
}

__device__ __forceinline__ void ret_intra(const bf16* QB, const bf16* KB, const bf16* VT, bf16* Ob, const float* decay_logit, int lane, int wave, int G) {
    const int r32 = lane & 31, hh = lane >> 5, qt = wave >> 1, dh = wave & 1, qi = 32 * qt + r32;
    for (int un = blockIdx.x; un < 512; un += G) { const int cg = un >> 2, h = un & 3;
        const float L2f = log2_sigmoid(decay_logit[h]), L2b = log2_sigmoid(decay_logit[4 + h]);
        f32x16 P[4];
#pragma unroll
        for (int kt = 0; kt < 4; ++kt)
#pragma unroll
            for (int g = 0; g < 16; ++g) P[kt][g] = 0.f;
        const bf16x8* qb = (const bf16x8*)QB + ((size_t)(h * 512 + cg * 4 + qt) * 16) * 64 + lane;
        const bf16x8* kb = (const bf16x8*)KB + ((size_t)(h * 512 + cg * 4) * 16) * 64 + lane;
#pragma unroll 4
        for (int s = 0; s < 16; ++s) { const bf16x8 bq = qb[s * 64];
#pragma unroll
            for (int kt = 0; kt < 4; ++kt) P[kt] = MFMA32(kb[(kt * 16 + s) * 64], bq, P[kt]); }
        bf16x8 pb[4][2];
#pragma unroll
        for (int kt = 0; kt < 4; ++kt) {
#pragma unroll
            for (int g = 0; g < 16; ++g) { const int kj = 32 * kt + (g & 3) + 8 * (g >> 2) + 4 * hh; const int d = qi - kj;
                P[kt][g] *= __builtin_amdgcn_exp2f(d >= 0 ? (float)d * L2f : (float)(-d) * L2b); }
#pragma unroll
            for (int s2 = 0; s2 < 2; ++s2) { u32x4 w; w.x = pk2(P[kt][8 * s2 + 0], P[kt][8 * s2 + 1]); w.y = pk2(P[kt][8 * s2 + 2], P[kt][8 * s2 + 3]);
                w.z = pk2(P[kt][8 * s2 + 4], P[kt][8 * s2 + 5]); w.w = pk2(P[kt][8 * s2 + 6], P[kt][8 * s2 + 7]); pb[kt][s2] = __builtin_bit_cast(bf16x8, w); }
        }
        const size_t tok = (size_t)cg * 128 + qi;
        for (int dvt = 0; dvt < 8; ++dvt) { const int dvtile = 8 * dh + dvt; f32x16 o;
#pragma unroll
            for (int g = 0; g < 16; ++g) o[g] = 0.f;
            const unsigned long long* vb = (const unsigned long long*)VT + (((size_t)(h * 128 + cg) * 16 + dvtile) * 8) * 128 + r32 * 2 + hh;
#pragma unroll
            for (int kt = 0; kt < 4; ++kt)
#pragma unroll
                for (int s2 = 0; s2 < 2; ++s2) { const int sb = 2 * kt + s2; u64x2 t2; t2.x = vb[sb * 128]; t2.y = vb[sb * 128 + 64];
                    o = MFMA32(__builtin_bit_cast(bf16x8, t2), pb[kt][s2], o); }
            bf16* op = Ob + tok * 2048 + 512 * h + 32 * dvtile + 4 * hh;
#pragma unroll
            for (int g4 = 0; g4 < 4; ++g4) { const unsigned long long w = (unsigned long long)pk2(o[4 * g4], o[4 * g4 + 1]) | ((unsigned long long)pk2(o[4 * g4 + 2], o[4 * g4 + 3]) << 32);
#ifdef R1_PLAIN_STORE
                *(unsigned long long*)(op + 8 * g4) = w; }
#else
                __hip_atomic_store((unsigned long long*)(op + 8 * g4), w, __ATOMIC_RELAXED, __HIP_MEMORY_SCOPE_AGENT); }
#endif
        }
    }
}

__device__ __forceinline__ void ret_scan(LAS unsigned char* lds, const bf16* QB, const bf16* KT, const bf16* VT, bf16* Ob, const float* decay_logit, int nseq, int seqlen, int tid, int lane, int wave, int G) {
    constexpr int ST_STRIDE = 528, ST_DIR = 32 * ST_STRIDE, ST_BYTES = 2 * ST_DIR, VL_OFF = 2 * ST_BYTES, VL_BYTES = 16384, ZT_OFF = VL_OFF + 2 * VL_BYTES;
    const int nc = seqlen >> 7, r32 = lane & 31, hh = lane >> 5, dir = wave >> 2, tt = wave & 3;
    const bf16x8* QBv = (const bf16x8*)QB; const bf16x8* KTv = (const bf16x8*)KT; const u32x4* VTv = (const u32x4*)VT;
    for (int item = blockIdx.x; item < nseq * 64; item += G) { const int sq = item >> 6, h = (item >> 4) & 3, sl = item & 15;
        const float L2f = log2_sigmoid(decay_logit[h]), L2b = log2_sigmoid(decay_logit[4 + h]);
        const float gCf = __builtin_amdgcn_exp2f(128.f * L2f), gCb = __builtin_amdgcn_exp2f(128.f * L2b);
        LAS float* ZT = (LAS float*)(lds + ZT_OFF);
        if (tid < 256) ZT[tid] = (tid < 128) ? __builtin_amdgcn_exp2f(L2f * (float)(127 - tid)) : __builtin_amdgcn_exp2f(L2b * (float)(tid - 128));
        for (int i = tid; i < ST_BYTES / 16; i += NTHREADS) ((LAS u32x4*)lds)[i] = (u32x4){0u, 0u, 0u, 0u};
        const int qi = 32 * tt + r32; const float xi = (dir == 0) ? __builtin_amdgcn_exp2f(L2f * (float)(qi + 1)) : __builtin_amdgcn_exp2f(L2b * (float)(128 - qi));
        const int cbase = sq * nc;
        f32x16 S0, S1;
#pragma unroll
        for (int g = 0; g < 16; ++g) { S0[g] = 0.f; S1[g] = 0.f; }
        bf16x8 Qf[16], Kf[8]; u32x4 Vr[2]; u32x2 Or[4];
        int cf = cbase, cb = cbase + nc - 1;
        const int vd = tid >> 8, u0 = tid & 255;
        { const int cq = dir == 0 ? cf : cb;
#pragma unroll
          for (int s = 0; s < 16; ++s) Qf[s] = QBv[((size_t)(h * 512 + cq * 4 + tt) * 16 + s) * 64 + lane]; }
#pragma unroll
        for (int s = 0; s < 8; ++s) Kf[s] = KTv[(((size_t)(h * 128 + cf) * 8 + wave) * 8 + s) * 64 + lane];
#pragma unroll
        for (int k = 0; k < 2; ++k) Vr[k] = VTv[((size_t)(h * 128 + (vd == 0 ? cf : cb)) * 16 + sl) * 512 + u0 + 256 * k];
        __syncthreads();
        for (int i = 0; i < nc; ++i) { const int buf = i & 1; const int in = (i + 1 < nc) ? i + 1 : i; const int cfn = cbase + in, cbn = cbase + nc - 1 - in;
            const int cq = dir == 0 ? cf : cb;
#pragma unroll
            for (int k = 0; k < 2; ++k) { const int u = u0 + 256 * k, j0 = 16 * ((u >> 6) & 7) + 8 * ((u >> 5) & 1); float f[8]; pg8::unpack8(Vr[k], f);
                const f32x4 z0 = *(const LAS f32x4*)(ZT + vd * 128 + j0), z1 = *(const LAS f32x4*)(ZT + vd * 128 + j0 + 4);
                f[0] *= z0.x; f[1] *= z0.y; f[2] *= z0.z; f[3] *= z0.w; f[4] *= z1.x; f[5] *= z1.y; f[6] *= z1.z; f[7] *= z1.w;
                *(LAS u32x4*)(lds + VL_OFF + buf * VL_BYTES + vd * 8192 + u * 16) = pg8::pack8(f); }
            {
                const int dmid = nc - 1 - 2 * i; if (dmid <= 5 && dmid >= -5) asm volatile("s_waitcnt vmcnt(0)" ::: "memory"); }
            asm volatile("s_waitcnt lgkmcnt(0)\n\ts_barrier" ::: "memory");
#pragma unroll
            for (int k = 0; k < 2; ++k) Vr[k] = VTv[((size_t)(h * 128 + (vd == 0 ? cfn : cbn)) * 16 + sl) * 512 + u0 + 256 * k];
            bf16* op = Ob + ((size_t)cq * 128 + qi) * 2048 + 512 * h + 32 * sl + 4 * hh;
#pragma unroll
            for (int g4 = 0; g4 < 4; ++g4) Or[g4] = *(const u32x2*)(op + 8 * g4);
            const LAS unsigned char* vlb = lds + VL_OFF + buf * VL_BYTES + lane * 16;
#pragma unroll
            for (int g = 0; g < 16; ++g) S0[g] *= gCf;
#pragma unroll
            for (int s = 0; s < 8; ++s) S0 = MFMA32(Kf[s], *(const LAS bf16x8*)(vlb + s * 1024), S0);
#pragma unroll
            for (int s = 0; s < 8; ++s) Kf[s] = KTv[(((size_t)(h * 128 + cb) * 8 + wave) * 8 + s) * 64 + lane];
            f32x16 cr;
#pragma unroll
            for (int g = 0; g < 16; ++g) cr[g] = 0.f;
            { const LAS unsigned char* stb = lds + buf * ST_BYTES + dir * ST_DIR + r32 * ST_STRIDE + hh * 16;
#pragma unroll
              for (int s = 0; s < 16; ++s) cr = MFMA32(*(const LAS bf16x8*)(stb + s * 32), Qf[s], cr); }
            { const int cqn = dir == 0 ? cfn : cbn;
#pragma unroll
              for (int s = 0; s < 16; ++s) Qf[s] = QBv[((size_t)(h * 512 + cqn * 4 + tt) * 16 + s) * 64 + lane]; }
#pragma unroll
            for (int g4 = 0; g4 < 4; ++g4) { u32x2 w;
                w.x = pk2(pg8::bflo(Or[g4].x) + cr[4 * g4] * xi, pg8::bfhi(Or[g4].x) + cr[4 * g4 + 1] * xi); w.y = pk2(pg8::bflo(Or[g4].y) + cr[4 * g4 + 2] * xi, pg8::bfhi(Or[g4].y) + cr[4 * g4 + 3] * xi);
                *(u32x2*)(op + 8 * g4) = w; }
#pragma unroll
            for (int g = 0; g < 16; ++g) S1[g] *= gCb;
#pragma unroll
            for (int s = 0; s < 8; ++s) S1 = MFMA32(Kf[s], *(const LAS bf16x8*)(vlb + 8192 + s * 1024), S1);
#pragma unroll
            for (int s = 0; s < 8; ++s) Kf[s] = KTv[(((size_t)(h * 128 + cfn) * 8 + wave) * 8 + s) * 64 + lane];
            { LAS unsigned char* wb = lds + (buf ^ 1) * ST_BYTES + r32 * ST_STRIDE + 64 * wave + 8 * hh;
#pragma unroll
              for (int g4 = 0; g4 < 4; ++g4) { u32x2 w; w.x = pk2(S0[4 * g4], S0[4 * g4 + 1]); w.y = pk2(S0[4 * g4 + 2], S0[4 * g4 + 3]); *(LAS u32x2*)(wb + 16 * g4) = w;
                  w.x = pk2(S1[4 * g4], S1[4 * g4 + 1]); w.y = pk2(S1[4 * g4 + 2], S1[4 * g4 + 3]); *(LAS u32x2*)(wb + ST_DIR + 16 * g4) = w; } }
            cf = cfn; cb = cbn;
        }
        __syncthreads();
    }
}

typedef float f32x4_ __attribute__((ext_vector_type(4)));
#define MFMA16(a, b, c) __builtin_amdgcn_mfma_f32_16x16x32_bf16((a), (b), (c), 0, 0, 0)
__device__ __forceinline__ void na_mfma(LAS unsigned char* lds, bf16* NQ, const bf16* NKB, const bf16* NVT, const float* rpb, int seqlen, int tid, int lane, int wave, int G) {
    LAS float* RP = (LAS float*)lds;
    for (int i = tid; i < 16 * 15 * 31; i += NTHREADS) RP[i] = rpb[i] * 1.4426950408889634f;
    __syncthreads();
    const int rows = seqlen >> 6, r16 = lane & 15, q4 = lane >> 4, g = wave & 3;
    const int c0 = (g == 0) ? 0 : ((g == 1) ? 8 : ((g == 2) ? 24 : 32)), c = 16 * g + r16;
    int cs = c - 8; cs = cs < 0 ? 0 : cs; cs = cs > 48 ? 48 : cs;
    constexpr int TB = TP / 8;
    for (int un = blockIdx.x; un < 256 * 8; un += G) { const int R = un >> 3, h = (un & 7) * 2 + (wave >> 2);
        const int r = R % rows, Rb = R - r; int rs = r - 4; rs = rs < 0 ? 0 : rs; rs = rs > rows - 8 ? rows - 8 : rs;
        const size_t tq = (size_t)R * 64 + c;
        bf16x8 qf[2];
#pragma unroll
        for (int ks = 0; ks < 2; ++ks) qf[ks] = *(const bf16x8*)(NQ + tq * 1024 + 64 * h + 32 * ks + 8 * q4);
        f32x4_ S[16];
#pragma unroll
        for (int kr = 0; kr < 8; ++kr) { const int tok0 = (Rb + rs + kr) * 64 + c0;
#pragma unroll
            for (int ch = 0; ch < 2; ++ch) { f32x4_ a = {0.f, 0.f, 0.f, 0.f};
#pragma unroll
                for (int ks = 0; ks < 2; ++ks) { const bf16x8 kf = *((const bf16x8*)NKB + ((size_t)(h * 2 + ks) * TB + ((tok0 + 16 * ch) >> 3) + (r16 >> 3)) * 32 + q4 * 8 + (r16 & 7));
                    a = MFMA16(kf, qf[ks], a); }
                S[2 * kr + ch] = a; } }
        float mx = -1e30f;
#pragma unroll
        for (int kr = 0; kr < 8; ++kr) { const LAS float* brow = RP + (h * 15 + (rs + kr - r + 7)) * 31 + 15 - c;
#pragma unroll
            for (int ch = 0; ch < 2; ++ch)
#pragma unroll
                for (int e = 0; e < 4; ++e) { const int kc = c0 + 16 * ch + 4 * q4 + e; const bool ok = (kc >= cs) && (kc < cs + 16);
                    const float s = ok ? S[2 * kr + ch][e] * 1.4426950408889634f + brow[ok ? kc : c] : -1e30f; S[2 * kr + ch][e] = s; mx = fmaxf(mx, s); } }
        mx = fmaxf(mx, __shfl_xor(mx, 16)); mx = fmaxf(mx, __shfl_xor(mx, 32));
        float l = 0.f;
#pragma unroll
        for (int t = 0; t < 16; ++t)
#pragma unroll
            for (int e = 0; e < 4; ++e) { const float p = __builtin_amdgcn_exp2f(S[t][e] - mx); S[t][e] = p; l += p; }
        l += __shfl_xor(l, 16); l += __shfl_xor(l, 32);
        const float il = 1.0f / l;
        f32x4_ O[4];
#pragma unroll
        for (int dt = 0; dt < 4; ++dt) O[dt] = (f32x4_){0.f, 0.f, 0.f, 0.f};
#pragma unroll
        for (int kr = 0; kr < 8; ++kr) { const int tok0 = (Rb + rs + kr) * 64 + c0;
            u32x4 w; w.x = pk2(S[2 * kr][0], S[2 * kr][1]); w.y = pk2(S[2 * kr][2], S[2 * kr][3]); w.z = pk2(S[2 * kr + 1][0], S[2 * kr + 1][1]); w.w = pk2(S[2 * kr + 1][2], S[2 * kr + 1][3]);
            const bf16x8 pf = __builtin_bit_cast(bf16x8, w);
            const int ta = tok0 + 4 * q4, tb = ta + 16;
#pragma unroll
            for (int dt = 0; dt < 4; ++dt) { u64x2 v2;
                v2.x = *((const unsigned long long*)NVT + (((size_t)h * TB + (ta >> 3)) * 64 + 16 * dt + r16) * 2 + ((ta >> 2) & 1));
                v2.y = *((const unsigned long long*)NVT + (((size_t)h * TB + (tb >> 3)) * 64 + 16 * dt + r16) * 2 + ((tb >> 2) & 1));
                O[dt] = MFMA16(__builtin_bit_cast(bf16x8, v2), pf, O[dt]); } }
#pragma unroll
        for (int dt = 0; dt < 4; ++dt) { u32x2 w; w.x = pk2(O[dt][0] * il, O[dt][1] * il); w.y = pk2(O[dt][2] * il, O[dt][3] * il);
            *(u32x2*)(NQ + tq * 1024 + 64 * h + 16 * dt + 4 * q4) = w; }
    }
    __syncthreads();
}

struct Args { const float* in[19]; float* out; unsigned char* ws; int ph_lo, ph_hi; };

__global__ void __launch_bounds__(NTHREADS, 2) fwd(Args args) {
    extern __shared__ __attribute__((aligned(16))) unsigned char lds_raw[];
    LAS unsigned char* lds = (LAS unsigned char*)lds_raw;
    for (int u = threadIdx.x; u < (LDS_BYTES - RING_BYTES) / 4; u += NTHREADS) ((LAS unsigned*)(lds + RING_BYTES))[u] = 0u;
    __syncthreads();
    if (args.ph_hi - args.ph_lo > 1) (void)xcd_barrier_post((unsigned*)(args.ws + WS_CTL) + CW_BAR, (volatile LAS unsigned*)(lds + MISC_OFF) + 8);
    for (int ph = args.ph_lo; ph < args.ph_hi; ++ph) {
    int tid = threadIdx.x; asm volatile("" : "+v"(tid));
    const int lane = tid & 63, wave = __builtin_amdgcn_readfirstlane(tid >> 6);
    const int G = gridDim.x, gw = blockIdx.x * NWAVES + wave, NGW = G * NWAVES;
    size_t zoff = 0; asm volatile("" : "+s"(zoff)); unsigned char* ws = args.ws + zoff;
    const float* x_prompt = args.in[0]; const float* x_sample = args.in[1]; const float* c_prompt = args.in[2]; const float* c_sample = args.in[3];
    const float* w_mod = args.in[4]; const float* b_mod = args.in[5]; const float* g_pre_mix = args.in[6]; const float* w_in = args.in[7];
    const float* rpb = args.in[8]; const float* decay_logit = args.in[9]; const float* ret_gn = args.in[10]; const float* w_up_na = args.in[11];
    const float* w_up_ret = args.in[12]; const float* w_out = args.in[13]; const float* g_post_mix = args.in[14]; const float* g_pre_ffn = args.in[15];
    const float* w_ffn_in = args.in[16]; const float* w_ffn_out = args.in[17]; const float* g_post_ffn = args.in[18];
    float* MODP = (float*)(ws + WS_MODP); float* MOD = (float*)(ws + WS_MOD);
    bf16* WIN = (bf16*)(ws + WS_WIN); bf16* WNA = (bf16*)(ws + WS_WNA); bf16* WRET = (bf16*)(ws + WS_WRET); bf16* WOUT = (bf16*)(ws + WS_WOUT);
    bf16* WFI = (bf16*)(ws + WS_WFI); bf16* WFO = (bf16*)(ws + WS_WFO);
    bf16* HA = (bf16*)(ws + WS_HA); bf16* HB = (bf16*)(ws + WS_HB); bf16* NQ = (bf16*)(ws + WS_NQ); bf16* NK = (bf16*)(ws + WS_NK); bf16* NV = (bf16*)(ws + WS_NV);
    bf16* KT = (bf16*)(ws + WS_KT); bf16* VT = (bf16*)(ws + WS_VT);
    bf16* Ob = (bf16*)(ws + WS_O); bf16* SG = (bf16*)(ws + WS_SG); bf16* MERGED = (bf16*)(ws + WS_MERGED);
    float* OUTMIX = (float*)(ws + WS_OUTMIX); bf16* H2 = (bf16*)(ws + WS_H2); bf16* ACT = (bf16*)(ws + WS_ACT); float* Fb = (float*)(ws + WS_F);
        if (ph == 0 && !(DIS & 1)) {
            LAS float* scr = (LAS float*)(lds + wave * 16384);
            constexpr int I_IN = 16 * 352, I_NA = 16 * 32, I_RET = 32 * 32, I_OUT = 16 * 32, I_FI = 16 * 176, I_FO = 44 * 32, I_MOD = 96 * 8;
            constexpr int NITEMS = I_IN + I_NA + I_RET + I_OUT + I_FI + I_FO + I_MOD;
            for (int it = gw; it < NITEMS; it += NGW) {
                int r = it;
                if (r < I_IN) { const int nb = r % 352, kb = r / 352; transpose_item(w_in, 1024, 11264, WIN, 64 * kb, 32 * nb, 32 * nb, scr, lane); continue; } r -= I_IN;
                if (r < I_NA) { const int nb = r % 32, kb = r / 32; transpose_item(w_up_na, 1024, 1024, WNA, 64 * kb, 32 * nb, 32 * nb, scr, lane); continue; } r -= I_NA;
                if (r < I_RET) { const int nb = r % 32, kb = r / 32; transpose_item(w_up_ret, 2048, 1024, WRET, 64 * kb, 32 * nb, 32 * nb, scr, lane); continue; } r -= I_RET;
                if (r < I_OUT) { const int nb = r % 32, kb = r / 32; transpose_item(w_out, 1024, 1024, WOUT, 64 * kb, 32 * nb, 32 * nb, scr, lane); continue; } r -= I_OUT;
                if (r < I_FI) { const int nb = r % 176, kb = r / 176; const int n0 = 32 * nb; const int j = (n0 < FFN) ? n0 : n0 - FFN;
                    const int drow = 256 * (j / 128) + (j % 128) + ((n0 < FFN) ? 0 : 128);
                    transpose_item(w_ffn_in, 1024, 2 * FFN, WFI, 64 * kb, n0, drow, scr, lane); continue; } r -= I_FI;
                if (r < I_FO) { const int nb = r % 32, kb = r / 32; transpose_item(w_ffn_out, FFN, 1024, WFO, 64 * kb, 32 * nb, 32 * nb, scr, lane); continue; } r -= I_FO;
                { const int strip = r % 96, kc = r / 96; const int j = strip * 64 + lane; float a0 = 0.f, a1 = 0.f, a2 = 0.f;
                    for (int k = kc * 128; k < kc * 128 + 128; ++k) { const float w = w_mod[(size_t)k * 6144 + j];
                        const float c0 = c_prompt[k], c1 = c_prompt[1024 + k], c2 = c_sample[k];
                        a0 += c0 * pg8::sigm(c0) * w; a1 += c1 * pg8::sigm(c1) * w; a2 += c2 * pg8::sigm(c2) * w; }
                    MODP[(kc * 3 + 0) * 6144 + j] = a0; MODP[(kc * 3 + 1) * 6144 + j] = a1; MODP[(kc * 3 + 2) * 6144 + j] = a2; }
            }
        } else if (ph == 1 && !(DIS & 2)) {
            for (int i = blockIdx.x * NTHREADS + tid; i < 3 * 6144; i += G * NTHREADS) { float s = b_mod[i % 6144];
#pragma unroll
                for (int kc = 0; kc < 8; ++kc) s += MODP[kc * 3 * 6144 + i];
                MOD[i] = s; }
        } else if (ph >= 2) {
            const int pass = (ph - 2) / NSTEP, step = (ph - 2) % NSTEP;
            const float* xin = pass == 0 ? x_sample : x_prompt; float* outp = args.out + (pass == 0 ? (size_t)TP * D : 0);
            const int seqlen = pass == 0 ? 16384 : 8192, seq0 = pass == 0 ? 2 : 0, nseq = pass == 0 ? 1 : 2;
            bf16* QB = (bf16*)outp; bf16* KB = QB + (size_t)TP * 1024; bf16* TNA = QB; bf16* NKB = QB; bf16* NVT = KB;
            if ((step == ST_H || step == ST_HGN) && !(DIS & 4)) {
                h_rows(xin, MOD, g_pre_mix, step == ST_H ? HA : HB, seq0, seqlen, gw, NGW, lane);
                if (step == ST_HGN) {
                    for (int t = gw; t < TP; t += NGW) {
#pragma unroll
                        for (int h = 0; h < 4; ++h) { bf16* p = Ob + (size_t)t * 2048 + 512 * h + 8 * lane; float f[8]; pg8::unpack8(*(const u32x4*)p, f);
                            float s = 0.f;
#pragma unroll
                            for (int e = 0; e < 8; ++e) s += f[e];
                            const float mu = wave_sum(s) * (1.f / 512.f); float q = 0.f;
#pragma unroll
                            for (int e = 0; e < 8; ++e) { f[e] -= mu; q += f[e] * f[e]; }
                            const float rstd = 1.0f / sqrtf(wave_sum(q) * (1.f / 512.f) + EPS);
                            const f32x4 g0 = *(const f32x4*)(ret_gn + 512 * h + 8 * lane), g1 = *(const f32x4*)(ret_gn + 512 * h + 8 * lane + 4);
                            f[0] *= rstd * g0.x; f[1] *= rstd * g0.y; f[2] *= rstd * g0.z; f[3] *= rstd * g0.w; f[4] *= rstd * g1.x; f[5] *= rstd * g1.y; f[6] *= rstd * g1.z; f[7] *= rstd * g1.w;
                            *(u32x4*)p = pg8::pack8(f); }
                    }
                }
            } else if ((step == ST_G1N || step == ST_G1R || step == ST_GATES || step == ST_G2 || step == ST_G3 || step == ST_G5) && !(DIS & 8)) {
                const int nparts = (step == ST_G1N || step == ST_GATES) ? 2 : 1;
                for (int part = 0; part < nparts; ++part) {
                    pg8::Gemm g; pg8::EpiBf E; E.o0 = nullptr; E.o1 = nullptr; E.o2 = nullptr; E.a1 = nullptr; E.a2 = nullptr; E.ldo = 1024; E.ld1 = 2048; E.ld2 = 1024; E.seqmask = seqlen - 1;
                    int skip_at = 1 << 30, skip_by = 0;
                    if (step == ST_G1N) {
                        if (part == 0)         { g = pg8::Gemm{HA, WIN, TP, 2048, 1024}; E.mode = 0; E.o0 = NQ; E.o1 = NKB; }
                        else                   { g = pg8::Gemm{WIN + (size_t)2048 * 1024, HA, 4096, TP, 1024}; E.mode = 7; E.o0 = KT; E.o1 = VT; E.o2 = NVT; skip_at = 4; skip_by = 4; }
                    } else if (step == ST_G1R) { g = pg8::Gemm{HA, WIN + (size_t)3072 * 1024, TP, 2048, 1024}; E.mode = 1; E.o0 = QB; E.o1 = KB;
                    } else if (step == ST_GATES) {
                        if (part == 0)         { g = pg8::Gemm{HB, WIN + (size_t)9216 * 1024, TP, 2048, 1024}; E.mode = 2; E.o0 = SG; E.ldo = 2048; }
                        else                   { g = pg8::Gemm{HB, WIN + (size_t)7168 * 1024, TP, 2048, 1024}; E.mode = 3; E.o0 = Ob; E.ldo = 2048; E.a1 = Ob; E.ld1 = 2048; }
                    }
                    else if (step == ST_G2)    { g = pg8::Gemm{NQ, WNA, TP, 1024, 1024}; E.mode = 4; E.o0 = TNA; E.ldo = 1024; E.a1 = SG; E.ld1 = 2048; }
                    else if (step == ST_G3)    { g = pg8::Gemm{Ob, WRET, TP, 1024, 2048}; E.mode = 5; E.o0 = MERGED; E.ldo = 1024; E.a1 = SG + 1024; E.ld1 = 2048; E.a2 = TNA; E.ld2 = 1024; }
                    else                       { g = pg8::Gemm{H2, WFI, TP, 2 * FFN, 1024}; E.mode = 6; E.o0 = ACT; E.ldo = FFN; }
                    pg8::StaticOrder S; S.init(g.M, g.N, G, (int)blockIdx.x); S.skip_at = skip_at; S.skip_by = skip_by;
                    pg8::gemm_phase<pg8::EpiBf, pg8::StaticOrder, true, true>(lds, g, S, E);
                    if (part + 1 < nparts) { asm volatile("s_waitcnt vmcnt(0) lgkmcnt(0)" ::: "memory"); __syncthreads(); }
                }
            } else if ((step == ST_G4 || step == ST_G6) && !(DIS & 16)) {
                pg8::Gemm g; pg8::EpiF32 E;
                if (step == ST_G4) { g = pg8::Gemm{MERGED, WOUT, TP, 1024, 1024}; E.C = OUTMIX; E.ldc = 1024; }
                else               { g = pg8::Gemm{ACT, WFO, TP, 1024, FFN}; E.C = Fb; E.ldc = 1024; }
                pg8::StaticOrder S; S.init(g.M, g.N, G, (int)blockIdx.x);
                pg8::gemm_phase<pg8::EpiF32, pg8::StaticOrder, true, true>(lds, g, S, E);
            } else if (step == ST_NA && !(DIS & 32)) {
                na_mfma(lds, NQ, NKB, NVT, rpb, seqlen, tid, lane, wave, G);
            } else if (step == ST_R1 && !(DIS & 64)) {
#ifdef PROBE_COPY_O
                for (size_t i = (size_t)blockIdx.x * NTHREADS + tid; i < (size_t)TP * 2048 / 8; i += (size_t)G * NTHREADS) ((u32x4*)Ob)[i] = (i & 1) ? ((const u32x4*)QB)[i] : ((const u32x4*)VT)[i];
#elif defined(PROBE_ZERO_O)
                for (size_t i = (size_t)blockIdx.x * NTHREADS + tid; i < (size_t)TP * 2048 / 8; i += (size_t)G * NTHREADS) ((u32x4*)Ob)[i] = (u32x4){0u, 0u, 0u, 0u};
#else
#ifdef PROBE_R1_TWICE
                ret_intra(QB, KB, VT, Ob, decay_logit, lane, wave, G);
#endif
                ret_intra(QB, KB, VT, Ob, decay_logit, lane, wave, G);
#endif
            } else if (step == ST_R2 && !(DIS & 512)) {
                ret_scan(lds, QB, KT, VT, Ob, decay_logit, nseq, seqlen, tid, lane, wave, G);
            } else if (step == ST_N1 && !(DIS & 128)) {
                for (int t = gw; t < TP; t += NGW) { const float* mod = MOD + (size_t)(seq0 + t / seqlen) * 6144;
                    const f32x4* orow = (const f32x4*)(OUTMIX + (size_t)t * D) + lane; const f32x4* xr = (const f32x4*)(xin + (size_t)t * D) + lane; f32x4 v[4]; float ss = 0.f;
#pragma unroll
                    for (int j = 0; j < 4; ++j) { v[j] = orow[64 * j]; ss += (v[j].x * v[j].x + v[j].y * v[j].y) + (v[j].z * v[j].z + v[j].w * v[j].w); }
                    const float rstd = 1.0f / sqrtf(wave_sum(ss) * (1.f / D) + EPS); float s2 = 0.f;
                    f32x4* o4 = (f32x4*)(outp + (size_t)t * D) + lane;
#pragma unroll
                    for (int j = 0; j < 4; ++j) { const int c = 4 * lane + 256 * j; const f32x4 g = *(const f32x4*)(g_post_mix + c), gt = *(const f32x4*)(mod + 2048 + c);
                        v[j] = xr[64 * j] + gt * (v[j] * rstd * g); o4[64 * j] = v[j]; s2 += (v[j].x * v[j].x + v[j].y * v[j].y) + (v[j].z * v[j].z + v[j].w * v[j].w); }
                    const float rstd2 = 1.0f / sqrtf(wave_sum(s2) * (1.f / D) + EPS);
                    u32x2* o8 = (u32x2*)(H2 + (size_t)t * D) + lane;
#pragma unroll
                    for (int j = 0; j < 4; ++j) { const int c = 4 * lane + 256 * j; const f32x4 g = *(const f32x4*)(g_pre_ffn + c), sh = *(const f32x4*)(mod + 3072 + c), sc = *(const f32x4*)(mod + 4096 + c);
                        const f32x4 h = v[j] * rstd2 * g * (sc + 1.0f) + sh; u32x2 w; w.x = pk2(h.x, h.y); w.y = pk2(h.z, h.w); o8[64 * j] = w; }
                }
            } else if (step == ST_N2 && !(DIS & 256)) {
                for (int t = gw; t < TP; t += NGW) { const float* mod = MOD + (size_t)(seq0 + t / seqlen) * 6144;
                    const f32x4* frow = (const f32x4*)(Fb + (size_t)t * D) + lane; f32x4* o4 = (f32x4*)(outp + (size_t)t * D) + lane; f32x4 v[4]; float ss = 0.f;
#pragma unroll
                    for (int j = 0; j < 4; ++j) { v[j] = frow[64 * j]; ss += (v[j].x * v[j].x + v[j].y * v[j].y) + (v[j].z * v[j].z + v[j].w * v[j].w); }
                    const float rstd = 1.0f / sqrtf(wave_sum(ss) * (1.f / D) + EPS);
#pragma unroll
                    for (int j = 0; j < 4; ++j) { const int c = 4 * lane + 256 * j; const f32x4 g = *(const f32x4*)(g_post_ffn + c), gt = *(const f32x4*)(mod + 5120 + c);
                        o4[64 * j] = o4[64 * j] + gt * (v[j] * rstd * g); }
                }
            }
        }
        if (ph + 1 < args.ph_hi) {
            if (ph == 0) cg::this_grid().sync();
            else { XcdBarrier bar; bar.bar = (unsigned*)(args.ws + WS_CTL) + CW_BAR; bar.x = xb_xcc_id(); bar.st = (volatile LAS unsigned*)(lds + MISC_OFF) + 8; xcd_barrier(bar); }
        }
    }
}

extern "C" void kernel_launch(void* const* d_in, const int* in_sizes, int n_in, void* d_out, int out_size, void* d_ws, size_t ws_size, hipStream_t stream) {
    static int grid = 0;
    if (grid == 0) {
        if (n_in != 19 || out_size != 2 * TP * D || ws_size < WS_END) { fprintf(stderr, "kernel_launch: unexpected shapes (n_in %d out %d ws %zu)\n", n_in, out_size, ws_size); grid = -1; return; }
        int dev = 0, cus = 0;
        if (hipGetDevice(&dev) != hipSuccess || hipDeviceGetAttribute(&cus, hipDeviceAttributeMultiprocessorCount, dev) != hipSuccess) { grid = -1; return; }
        if (hipFuncSetAttribute((const void*)fwd, hipFuncAttributeMaxDynamicSharedMemorySize, LDS_BYTES) != hipSuccess) { fprintf(stderr, "kernel_launch: hipFuncSetAttribute failed\n"); grid = -1; return; }
        grid = cus;
    }
    if (grid < 0) return;
    Args a{};
    for (int i = 0; i < 19; ++i) a.in[i] = (const float*)d_in[i];
    a.out = (float*)d_out; a.ws = (unsigned char*)d_ws;
#if ONE_LAUNCH
    if (hipMemsetAsync((char*)d_ws + WS_CTL, 0, CTL_ZERO_BYTES, stream) != hipSuccess) { fprintf(stderr, "kernel_launch: memset failed\n"); return; }
    a.ph_lo = 0; a.ph_hi = NPHASE;
    void* kargs[] = {&a};
    const hipError_t e = hipLaunchCooperativeKernel((const void*)fwd, dim3(grid), dim3(NTHREADS), kargs, LDS_BYTES, stream);
    if (e != hipSuccess) fprintf(stderr, "kernel_launch: cooperative launch failed: %s (grid %d)\n", hipGetErrorString(e), grid);
#else
    for (int ph = 0; ph < NPHASE; ++ph) { a.ph_lo = ph; a.ph_hi = ph + 1; hipLaunchKernelGGL(fwd, dim3(grid), dim3(NTHREADS), LDS_BYTES, stream, a); }
#endif
}
```

```cpp
#include <hip/hip_runtime.h>
#include <hip/hip_cooperative_groups.h>
#include <cstdio>
#include <cstdint>
__device__ const float INVT[128] = {1.591549367e-01f, 1.481051445e-01f, 1.378225088e-01f, 1.282537729e-01f, 1.193493679e-01f, 1.110631898e-01f, 1.033522934e-01f, 9.617675841e-02f, 8.949939907e-02f, 8.328563720e-02f, 7.750328630e-02f, 7.212239504e-02f, 6.711508334e-02f, 6.245541945e-02f, 5.811926723e-02f, 5.408416688e-02f, 5.032921210e-02f, 4.683495685e-02f, 4.358330369e-02f, 4.055740312e-02f, 3.774158657e-02f, 3.512126207e-02f, 3.268286586e-02f, 3.041376173e-02f, 2.830219641e-02f, 2.633723244e-02f, 2.450869232e-02f, 2.280710265e-02f, 2.122365311e-02f, 1.975013874e-02f, 1.837892644e-02f, 1.710291393e-02f, 1.591549441e-02f, 1.481051371e-02f, 1.378225069e-02f, 1.282537635e-02f, 1.193493698e-02f, 1.110631879e-02f, 1.033522934e-02f, 9.617676027e-03f, 8.949940093e-03f, 8.328564465e-03f, 7.750329096e-03f, 7.212239318e-03f, 6.711508147e-03f, 6.245541852e-03f, 5.811926909e-03f, 5.408416502e-03f, 5.032921210e-03f, 4.683495965e-03f, 4.358330276e-03f, 4.055740312e-03f, 3.774158424e-03f, 3.512126394e-03f, 3.268286586e-03f, 3.041376127e-03f, 2.830219688e-03f, 2.633723198e-03f, 2.450869186e-03f, 2.280710265e-03f, 2.122365171e-03f, 1.975013874e-03f, 1.837892574e-03f, 1.710291486e-03f, 1.591549488e-03f, 1.481051440e-03f, 1.378225046e-03f, 1.282537705e-03f, 1.193493721e-03f, 1.110631856e-03f, 1.033523004e-03f, 9.617675678e-04f, 8.949940093e-04f, 8.328563999e-04f, 7.750329096e-04f, 7.212239434e-04f, 6.711508031e-04f, 6.245541736e-04f, 5.811926676e-04f, 5.408416619e-04f, 5.032921326e-04f, 4.683495790e-04f, 4.358330334e-04f, 4.055740137e-04f, 3.774158540e-04f, 3.512126277e-04f, 3.268286528e-04f, 3.041376185e-04f, 2.830219455e-04f, 2.633723198e-04f, 2.450869069e-04f, 2.280710323e-04f, 2.122365258e-04f, 1.975013729e-04f, 1.837892632e-04f, 1.710291544e-04f, 1.591549371e-04f, 1.481051440e-04f, 1.378224988e-04f, 1.282537705e-04f, 1.193493736e-04f, 1.110631856e-04f, 1.033522931e-04f, 9.617675823e-05f, 8.949940093e-05f, 8.328563854e-05f, 7.750328950e-05f, 7.212239143e-05f, 6.711508468e-05f, 6.245542318e-05f, 5.811926894e-05f, 5.408416473e-05f, 5.032921035e-05f, 4.683495717e-05f, 4.358330261e-05f, 4.055740283e-05f, 3.774158540e-05f, 3.512126204e-05f, 3.268286673e-05f, 3.041376112e-05f, 2.830219637e-05f, 2.633723125e-05f, 2.450869215e-05f, 2.280710396e-05f, 2.122365186e-05f, 1.975013765e-05f, 1.837892523e-05f, 1.710291508e-05f};
namespace pg8 {
#define PG8_LAS __attribute__((address_space(3)))
typedef unsigned short bf16_t;
typedef short bf16x8 __attribute__((ext_vector_type(8)));
typedef float f32x4 __attribute__((ext_vector_type(4)));
typedef unsigned u32x4 __attribute__((ext_vector_type(4)));
constexpr int BM = 256, BK = 64, HALF = 128, HTB = HALF * BK * 2  , STAGE_BYTES = 8 * HTB, NXCD = 8, WGM = 8;

__host__ __device__ __forceinline__ int lds_byte(int r, int c) { const int st = (r >> 4) * 2 + (c >> 5), rr = r & 15, cc = c & 31, ob = rr * 64 + cc * 2; return st * 1024 + (ob ^ (((ob >> 9) & 1) << 5)); }
__host__ __device__ __forceinline__ void stage_rc(int b, int& R, int& C) { const int st = b / 1024, sb = b % 1024, swz = sb ^ (((sb >> 9) & 1) << 5); R = (st >> 1) * 16 + swz / 64; C = (st & 1) * 32 + (swz % 64) / 2; }
__host__ __device__ __forceinline__ int perm32(int rho) { const int n = rho >> 4, i = rho & 15; return 8 * (i >> 2) + 4 * n + (i & 3); }

struct Unit { int pm, pn; };
struct Gemm { const bf16_t* A; const bf16_t* Bt; int M, N, K; };

struct StaticOrder {
    int nM, nN, nwg, G, c, skip_at, skip_by;
    __host__ __device__ void init(int M, int N, int G_, int c_) { nM = M / BM; nN = N / BM; nwg = nM * nN; G = G_; c = c_; skip_at = 1 << 30; skip_by = 0; }
    __host__ __device__ bool next(int i, Unit& u) const {
        const long L = (long)i * G + c; if (L >= nwg) return false;
        int wgid = (int)L; { const int q = nwg / NXCD, r = nwg % NXCD, xcd = wgid % NXCD, off = wgid / NXCD; wgid = (xcd < r ? xcd * (q + 1) : r * (q + 1) + (xcd - r) * q) + off; }
        const int nig = WGM * nN, gid = wgid / nig, fm = gid * WGM, gsz = (nM - fm) < WGM ? (nM - fm) : WGM;
        u.pm = fm + ((wgid % nig) % gsz); u.pn = (wgid % nig) / gsz; if (u.pm >= skip_at) u.pm += skip_by; return true;
    }
    __device__ __forceinline__ void a_ready(const Unit&) const {}
    __device__ __forceinline__ void done(const Unit&) const {}
};
typedef float f32x2_cv __attribute__((ext_vector_type(2))); typedef __bf16 bf16x2_cv __attribute__((ext_vector_type(2)));
__device__ __forceinline__ unsigned cvt_pk_bf16(float lo, float hi) { const f32x2_cv v = {lo, hi}; return __builtin_bit_cast(unsigned, __builtin_convertvector(v, bf16x2_cv)); }
__device__ __forceinline__ float bflo(unsigned w) { return __uint_as_float(w << 16); }
__device__ __forceinline__ float bfhi(unsigned w) { return __uint_as_float(w & 0xffff0000u); }
__device__ __forceinline__ float sigm(float x) { return __builtin_amdgcn_rcpf(1.f + __expf(-x)); }
__device__ __forceinline__ void unpack8(const u32x4 w, float (&f)[8]) {
    f[0] = bflo(w.x); f[1] = bfhi(w.x); f[2] = bflo(w.y); f[3] = bfhi(w.y); f[4] = bflo(w.z); f[5] = bfhi(w.z); f[6] = bflo(w.w); f[7] = bfhi(w.w); }
__device__ __forceinline__ u32x4 pack8(const float (&f)[8]) {
    u32x4 w; w.x = cvt_pk_bf16(f[0], f[1]); w.y = cvt_pk_bf16(f[2], f[3]); w.z = cvt_pk_bf16(f[4], f[5]); w.w = cvt_pk_bf16(f[6], f[7]); return w; }

struct EpiF32 {
    static constexpr bool PERM = false, AFTER_DRAIN = false;
    float* C; int ldc;
    __device__ __forceinline__ void operator()(const f32x4 (&acc)[2][2][4][2], const Unit& u, int wr, int wc, int fr, int fq) const {
        asm volatile("" : "+v"(fr), "+v"(fq));
        const int row0 = u.pm * BM + wr * 64 + fr, col0 = u.pn * BM + wc * 32 + 4 * fq;
#pragma unroll
        for (int ai = 0; ai < 2; ++ai)
#pragma unroll
            for (int m = 0; m < 4; ++m) { float* rowp = C + (size_t)(row0 + ai * HALF + m * 16) * ldc + col0;
#pragma unroll
                for (int bj = 0; bj < 2; ++bj)
#pragma unroll
                    for (int n = 0; n < 2; ++n) *(f32x4*)(rowp + bj * HALF + n * 16) = acc[ai][bj][m][n]; }
    }
};

struct EpiBf {
    static constexpr bool PERM = true, AFTER_DRAIN = false;
    int mode; bf16_t *o0, *o1, *o2; const bf16_t *a1, *a2; int ldo, ld1, ld2, seqmask;
    __device__ __forceinline__ void operator()(const f32x4 (&acc)[2][2][4][2], const Unit& u, int wr, int wc, int fr, int fq) const {
        asm volatile("" : "+v"(fr), "+v"(fq));
        const int row0 = u.pm * BM + wr * 64 + fr, cin = wc * 32 + 8 * fq;
        if (mode == 1) {
            bf16_t* base = (u.pn < 4) ? o0 : o1; const float sc = (u.pn < 4) ? 1.f : 0.0625f; const int h = u.pn & 3;
            float it[8];
#pragma unroll
            for (int e = 0; e < 8; ++e) it[e] = INVT[cin + e];
            const int s1 = cin >> 4, hb = (cin >> 3) & 1;
#pragma unroll
            for (int ai = 0; ai < 2; ++ai)
#pragma unroll
                for (int m = 0; m < 4; ++m) { const int row = row0 + ai * HALF + m * 16; const float pos = (float)(row & seqmask);
                    float r1[8], r2[8];
#pragma unroll
                    for (int e = 0; e < 8; ++e) { const float x1 = acc[ai][0][m][e >> 2][e & 3], x2 = acc[ai][1][m][e >> 2][e & 3];
                        const float f = __builtin_amdgcn_fractf(pos * it[e]); const float s = __builtin_amdgcn_sinf(f), c = __builtin_amdgcn_cosf(f);
                        r1[e] = (x1 * c - x2 * s) * sc; r2[e] = (x1 * s + x2 * c) * sc; }
                    bf16_t* p = base + ((((size_t)(h * 512 + (row >> 5)) * 16 + s1) * 64 + hb * 32 + (row & 31)) << 3);
                    *(u32x4*)p = pack8(r1); *(u32x4*)(p + 8 * 64 * 8) = pack8(r2); }
            return;
        }
        if (mode == 7) {
            const int t0 = u.pn * BM + cin;
            if (u.pm < 4) {
#pragma unroll
                for (int ai = 0; ai < 2; ++ai)
#pragma unroll
                    for (int m = 0; m < 4; ++m) { const int wrow = u.pm * 256 + ai * HALF + wr * 64 + m * 16 + fr, hd = wrow >> 6, dh = wrow & 63;
#pragma unroll
                        for (int bj = 0; bj < 2; ++bj) { const int t = t0 + bj * HALF; float r[8];
#pragma unroll
                            for (int e = 0; e < 8; ++e) r[e] = acc[ai][bj][m][e >> 2][e & 3];
                            *(u32x4*)(o2 + ((((size_t)hd * 2048 + (t >> 3)) * 64 + dh) << 3)) = pack8(r); } }
            } else if (u.pm < 12) { const int h = u.pm - 8;
#pragma unroll
                for (int m = 0; m < 4; ++m) { const int i = wr * 64 + m * 16 + fr; const float itv = INVT[i];
#pragma unroll
                    for (int bj = 0; bj < 2; ++bj) { const int t = t0 + bj * HALF; float r1[8], r2[8];
#pragma unroll
                        for (int e = 0; e < 8; ++e) { const float x1 = acc[0][bj][m][e >> 2][e & 3], x2 = acc[1][bj][m][e >> 2][e & 3]; const float pos = (float)((t + e) & seqmask);
                            const float f = __builtin_amdgcn_fractf(pos * itv); const float s = __builtin_amdgcn_sinf(f), c = __builtin_amdgcn_cosf(f);
                            r1[e] = (x1 * c - x2 * s) * 0.0625f; r2[e] = (x1 * s + x2 * c) * 0.0625f; }
                        bf16_t* p = o0 + ((((((size_t)(h * 128 + (t >> 7)) * 8 + (i >> 5)) * 8 + ((t & 127) >> 4)) * 64) + ((t >> 3) & 1) * 32 + (i & 31)) << 3);
                        *(u32x4*)p = pack8(r1); *(u32x4*)(p + 4 * 8 * 64 * 8) = pack8(r2); } }
            } else {
#pragma unroll
                for (int ai = 0; ai < 2; ++ai)
#pragma unroll
                    for (int m = 0; m < 4; ++m) { const int dvg = (u.pm - 12) * 256 + ai * HALF + wr * 64 + m * 16 + fr, h = dvg >> 9, dv = dvg & 511;
#pragma unroll
                        for (int bj = 0; bj < 2; ++bj) { const int t = t0 + bj * HALF; float r[8];
#pragma unroll
                            for (int e = 0; e < 8; ++e) r[e] = acc[ai][bj][m][e >> 2][e & 3];
                            bf16_t* p = o1 + ((((((size_t)(h * 128 + (t >> 7)) * 16 + (dv >> 5)) * 8 + ((t & 127) >> 4)) * 64) + ((t >> 3) & 1) * 32 + (dv & 31)) << 3);
                            *(u32x4*)p = pack8(r); } }
            }
            return;
        }
        if (mode == 6) {
            const int ocol = u.pn * 128 + cin;
#pragma unroll
            for (int ai = 0; ai < 2; ++ai)
#pragma unroll
                for (int m = 0; m < 4; ++m) { const int row = row0 + ai * HALF + m * 16; float r[8];
#pragma unroll
                    for (int e = 0; e < 8; ++e) { const float a = acc[ai][0][m][e >> 2][e & 3], g = acc[ai][1][m][e >> 2][e & 3]; r[e] = a * sigm(a) * g; }
                    *(u32x4*)(o0 + (size_t)row * ldo + ocol) = pack8(r); }
            return;
        }
        bf16_t* ob = o0; int ocol = u.pn * BM + cin, ld = ldo; float sc = 1.f;
        if (mode == 0 && u.pn >= 4) {
#pragma unroll
            for (int ai = 0; ai < 2; ++ai)
#pragma unroll
                for (int m = 0; m < 4; ++m) { const int row = row0 + ai * HALF + m * 16;
#pragma unroll
                    for (int bj = 0; bj < 2; ++bj) { const int cc = bj * HALF + cin, h = (u.pn - 4) * 4 + (cc >> 6), dh0 = cc & 63; float r[8];
#pragma unroll
                        for (int e = 0; e < 8; ++e) r[e] = acc[ai][bj][m][e >> 2][e & 3];
                        *(u32x4*)(o1 + ((((((size_t)(h * 2 + (dh0 >> 5)) * 2048 + (row >> 3)) * 4 + ((dh0 >> 3) & 3)) * 8) + (row & 7)) << 3)) = pack8(r); } }
            return;
        }
        if (mode == 0) { sc = 0.125f; ld = 1024; }
#pragma unroll
        for (int ai = 0; ai < 2; ++ai)
#pragma unroll
            for (int m = 0; m < 4; ++m) { const int row = row0 + ai * HALF + m * 16;
#pragma unroll
                for (int bj = 0; bj < 2; ++bj) { const int col = ocol + bj * HALF; float r[8];
#pragma unroll
                    for (int e = 0; e < 8; ++e) r[e] = acc[ai][bj][m][e >> 2][e & 3];
                    if (mode == 0) {
#pragma unroll
                        for (int e = 0; e < 8; ++e) r[e] *= sc;
                    } else if (mode == 2) {
#pragma unroll
                        for (int e = 0; e < 8; ++e) r[e] = sigm(r[e]);
                    } else {
                        float x[8]; unpack8(*(const u32x4*)(a1 + (size_t)row * ld1 + col), x);
                        if (mode == 3) {
#pragma unroll
                            for (int e = 0; e < 8; ++e) r[e] = r[e] * sigm(r[e]) * x[e];
                        } else if (mode == 4) {
#pragma unroll
                            for (int e = 0; e < 8; ++e) r[e] = r[e] * x[e];
                        } else {
                            float y[8]; unpack8(*(const u32x4*)(a2 + (size_t)row * ld2 + col), y);
#pragma unroll
                            for (int e = 0; e < 8; ++e) r[e] = y[e] + r[e] * x[e];
                        }
                    }
                    *(u32x4*)(ob + (size_t)row * ld + col) = pack8(r); } }
    }
};

template <class Epi, class Sched, bool ALIGN_EPI = false, bool SP2 = false>
__device__ __forceinline__ void gemm_phase(PG8_LAS unsigned char* lds, const Gemm g, const Sched& S, const Epi& E) {
    int tid = threadIdx.x; asm volatile("" : "+v"(tid));
    const int wid = __builtin_amdgcn_readfirstlane(tid >> 6), lane = tid & 63, wr = wid >> 2, wc = wid & 3, fr = lane & 15, fq = lane >> 4;
    const int K = g.K, nt = K / BK;
    unsigned voffA[2], voffB[2];
#pragma unroll
    for (int i = 0; i < 2; ++i) { int R, C; stage_rc(tid * 16 + i * 8192, R, C); const int Rb = Epi::PERM ? ((R & ~31) + perm32(R & 31)) : R;
        voffA[i] = (unsigned)(R * K + C) * 2u; voffB[i] = (unsigned)(Rb * K + C) * 2u; }
    const size_t kstep = (size_t)(BK * 2);
    const size_t hstep = (size_t)HALF * K * 2;
    const size_t tstep = 2 * hstep;
    const unsigned ldsw = (unsigned)wid * 1024u;
    const int aoff = lds_byte(wr * 64 + fr, fq * 8), boff = lds_byte(wc * 32 + fr, fq * 8);
#define PG8_SA(b, h) (((b) * 2 + (h)) * HTB)
#define PG8_SB(b, h) ((4 + (b) * 2 + (h)) * HTB)
#define PG8_STAGE(bufoff, gbase, voff) do { _Pragma("unroll") for (int _i = 0; _i < 2; ++_i) \
        __builtin_amdgcn_global_load_lds((const unsigned*)((const char*)(gbase) + (voff)[_i]), (PG8_LAS unsigned*)(lds + (bufoff) + ldsw + _i * 8192), 16, 0, 0); } while (0)
#define PG8_LDA(dst, b, h) do { _Pragma("unroll") for (int m = 0; m < 4; ++m) _Pragma("unroll") for (int k = 0; k < 2; ++k) dst[m][k] = *(const PG8_LAS bf16x8*)(lds + PG8_SA(b, h) + aoff + m * 2048 + k * 1024); } while (0)
#define PG8_LDB(dst, b, h) do { _Pragma("unroll") for (int n = 0; n < 2; ++n) _Pragma("unroll") for (int k = 0; k < 2; ++k) dst[n][k] = *(const PG8_LAS bf16x8*)(lds + PG8_SB(b, h) + boff + n * 2048 + k * 1024); } while (0)
#define PG8_MMA(ai, bj, At, Bt) do { __builtin_amdgcn_s_setprio(1); _Pragma("unroll") for (int m = 0; m < 4; ++m) _Pragma("unroll") for (int n = 0; n < 2; ++n) _Pragma("unroll") for (int k = 0; k < 2; ++k) \
        acc[ai][bj][m][n] = __builtin_amdgcn_mfma_f32_16x16x32_bf16(Bt[n][k], At[m][k], acc[ai][bj][m][n], 0, 0, 0); __builtin_amdgcn_s_setprio(0); } while (0)
#define PG8_WAIT_V(n) asm volatile("s_waitcnt vmcnt(" #n ")" ::: "memory")
#define PG8_WAIT_L(n) asm volatile("s_waitcnt lgkmcnt(" #n ")" ::: "memory")
#define PG8_BAR __builtin_amdgcn_s_barrier()
#define PG8_SCHED __builtin_amdgcn_sched_barrier(0)
    Unit cur, nxt; int ui = 0;
    if (!S.next(0, cur)) return;
    f32x4 acc[2][2][4][2];
#pragma unroll
    for (int a = 0; a < 2; ++a)
#pragma unroll
        for (int b = 0; b < 2; ++b)
#pragma unroll
            for (int m = 0; m < 4; ++m)
#pragma unroll
                for (int n = 0; n < 2; ++n) acc[a][b][m][n] = (f32x4){0.f, 0.f, 0.f, 0.f};
    bf16x8 At[4][2], B0[2][2], B1[2][2];
    const char* cA = (const char*)g.A + (size_t)cur.pm * tstep; const char* cB = (const char*)g.Bt + (size_t)cur.pn * tstep;
    S.a_ready(cur);
    if constexpr (SP2) {
        PG8_STAGE(PG8_SB(0, 0), cB, voffB); PG8_STAGE(PG8_SB(0, 1), cB + hstep, voffB); PG8_STAGE(PG8_SA(0, 0), cA, voffA); PG8_STAGE(PG8_SA(0, 1), cA + hstep, voffA);
        if (wr == 1) PG8_BAR;
        PG8_WAIT_V(2); PG8_BAR;
        PG8_STAGE(PG8_SB(1, 0), cB + kstep, voffB); PG8_STAGE(PG8_SA(1, 0), cA + kstep, voffA); PG8_STAGE(PG8_SB(1, 1), cB + hstep + kstep, voffB);
        PG8_WAIT_V(6); PG8_BAR;
    } else {
        PG8_STAGE(PG8_SB(0, 0), cB, voffB); PG8_STAGE(PG8_SA(0, 0), cA, voffA); PG8_STAGE(PG8_SB(0, 1), cB + hstep, voffB); PG8_STAGE(PG8_SA(0, 1), cA + hstep, voffA);
        if (wr == 1) PG8_BAR;
        PG8_WAIT_V(4); PG8_BAR;
        PG8_STAGE(PG8_SB(1, 0), cB + kstep, voffB); PG8_STAGE(PG8_SA(1, 0), cA + kstep, voffA); PG8_STAGE(PG8_SB(1, 1), cB + hstep + kstep, voffB);
        PG8_WAIT_V(6); PG8_BAR;
    }
    for (;;) {
        const bool has_next = S.next(ui + 1, nxt);
        const char* nA = has_next ? (const char*)g.A + (size_t)nxt.pm * tstep : cA; const char* nB = has_next ? (const char*)g.Bt + (size_t)nxt.pn * tstep : cB;
        for (int t = 0; t < nt; t += 2) {
            const bool last = (t == nt - 2);
            const char* a1 = cA + (size_t)(t + 1) * kstep;
            const char* a2 = last ? nA : cA + (size_t)(t + 2) * kstep; const char* b2 = last ? nB : cB + (size_t)(t + 2) * kstep;
            const char* a3 = a2 + kstep; const char* b3 = b2 + kstep;
            if (last && has_next) S.a_ready(nxt);
            if constexpr (SP2) {
            PG8_LDB(B0, 0, 0); PG8_LDB(B1, 0, 1); PG8_SCHED; PG8_LDA(At, 0, 0); PG8_STAGE(PG8_SA(1, 1), a1 + hstep, voffA);
            PG8_WAIT_V(8); PG8_WAIT_L(0); PG8_BAR; PG8_MMA(0, 0, At, B0); PG8_MMA(0, 1, At, B1); PG8_BAR; PG8_SCHED;
            PG8_LDA(At, 0, 1); PG8_STAGE(PG8_SB(0, 0), b2, voffB); PG8_STAGE(PG8_SB(0, 1), b2 + hstep, voffB); PG8_STAGE(PG8_SA(0, 0), a2, voffA);
            PG8_WAIT_V(8); PG8_WAIT_L(0); PG8_BAR; PG8_MMA(1, 0, At, B0); PG8_MMA(1, 1, At, B1); PG8_BAR; PG8_SCHED;
            PG8_LDB(B0, 1, 0); PG8_LDB(B1, 1, 1); PG8_SCHED; PG8_LDA(At, 1, 0); PG8_STAGE(PG8_SA(0, 1), a2 + hstep, voffA);
            PG8_WAIT_V(8); PG8_WAIT_L(0); PG8_BAR; PG8_MMA(0, 0, At, B0); PG8_MMA(0, 1, At, B1); PG8_BAR; PG8_SCHED;
            PG8_LDA(At, 1, 1); PG8_STAGE(PG8_SB(1, 0), b3, voffB); PG8_STAGE(PG8_SB(1, 1), b3 + hstep, voffB); PG8_STAGE(PG8_SA(1, 0), a3, voffA);
            PG8_WAIT_V(8); PG8_WAIT_L(0); PG8_BAR; PG8_MMA(1, 0, At, B0); PG8_MMA(1, 1, At, B1); PG8_BAR; PG8_SCHED;
            } else {
            PG8_LDB(B0, 0, 0); PG8_SCHED; PG8_LDA(At, 0, 0); PG8_STAGE(PG8_SA(1, 1), a1 + hstep, voffA);
            PG8_WAIT_L(8); PG8_BAR; PG8_WAIT_L(0); PG8_MMA(0, 0, At, B0); PG8_BAR; PG8_SCHED;
            PG8_LDB(B1, 0, 1); PG8_STAGE(PG8_SB(0, 0), b2, voffB);
            PG8_BAR; PG8_WAIT_L(0); PG8_MMA(0, 1, At, B1); PG8_BAR;
            PG8_LDA(At, 0, 1); PG8_STAGE(PG8_SA(0, 0), a2, voffA);
            PG8_BAR; PG8_WAIT_L(0); PG8_MMA(1, 0, At, B0); PG8_BAR; PG8_SCHED;
            PG8_STAGE(PG8_SB(0, 1), b2 + hstep, voffB);
            PG8_WAIT_V(6); PG8_BAR; PG8_MMA(1, 1, At, B1); PG8_BAR;
            PG8_LDB(B0, 1, 0); PG8_SCHED; PG8_LDA(At, 1, 0); PG8_STAGE(PG8_SA(0, 1), a2 + hstep, voffA);
            PG8_WAIT_L(8); PG8_BAR; PG8_WAIT_L(0); PG8_MMA(0, 0, At, B0); PG8_BAR; PG8_SCHED;
            PG8_LDB(B1, 1, 1); PG8_STAGE(PG8_SB(1, 0), b3, voffB);
            PG8_BAR; PG8_WAIT_L(0); PG8_MMA(0, 1, At, B1); PG8_BAR;
            PG8_LDA(At, 1, 1); PG8_STAGE(PG8_SA(1, 0), a3, voffA);
            PG8_BAR; PG8_WAIT_L(0); PG8_MMA(1, 0, At, B0); PG8_BAR; PG8_SCHED;
            PG8_STAGE(PG8_SB(1, 1), b3 + hstep, voffB);
            PG8_WAIT_V(6); PG8_BAR; PG8_MMA(1, 1, At, B1); PG8_BAR;
            }
        }
        if constexpr (ALIGN_EPI) { if (wr == 0) PG8_BAR; }
        if constexpr (!Epi::AFTER_DRAIN) { E(acc, cur, wr, wc, fr, fq); S.done(cur); }
        if (!has_next) break;
#pragma unroll
        for (int a = 0; a < 2; ++a)
#pragma unroll
            for (int b = 0; b < 2; ++b)
#pragma unroll
                for (int m = 0; m < 4; ++m)
#pragma unroll
                    for (int n = 0; n < 2; ++n) acc[a][b][m][n] = (f32x4){0.f, 0.f, 0.f, 0.f};
        cur = nxt; cA = nA; cB = nB; ++ui;
        if constexpr (ALIGN_EPI) { if (wr == 1) PG8_BAR; }
    }
    PG8_WAIT_V(0);
    if constexpr (!ALIGN_EPI) { if (wr == 0) PG8_BAR; }
    PG8_BAR;
    if constexpr (Epi::AFTER_DRAIN) { E.fused(acc, cur, wr, wc, fr, fq, lds, wid, lane); S.done(cur); }
#undef PG8_SA
#undef PG8_SB
#undef PG8_STAGE
#undef PG8_LDA
#undef PG8_LDB
#undef PG8_MMA
#undef PG8_WAIT_V
#undef PG8_WAIT_L
#undef PG8_BAR
#undef PG8_SCHED
}
}
namespace cg = cooperative_groups;
#define LAS __attribute__((address_space(3)))
typedef unsigned short bf16;
typedef float f32x4 __attribute__((ext_vector_type(4)));
typedef unsigned u32x4 __attribute__((ext_vector_type(4)));
typedef unsigned u32x2 __attribute__((ext_vector_type(2)));

constexpr int NWAVES = 8, NTHREADS = 512;
constexpr int D = 1024, TP = 16384;
constexpr int FFN = 2816;
constexpr float EPS = 1e-6f;
enum { ST_H = 0, ST_G1N, ST_NA, ST_G1R, ST_R1, ST_R2A, ST_R2, ST_HGN, ST_GATES, ST_G2, ST_G3, ST_G4, ST_N1, ST_G5, ST_G6, ST_N2, NSTEP };
constexpr int NPHASE = 2 + 2 * NSTEP;
constexpr int LDS_BYTES = 147456;
#ifndef DIS_MASK
#define DIS_MASK 0
#endif
constexpr unsigned DIS = DIS_MASK;

constexpr size_t MiB = 1u << 20;
constexpr size_t WS_CTL = 0, WS_MODP = 64 * 1024, WS_MOD = 704 * 1024;
constexpr size_t WS_WIN = 1 * MiB, WS_WNA = 23 * MiB, WS_WRET = 25 * MiB, WS_WOUT = 29 * MiB, WS_WFI = 31 * MiB, WS_WFO = 42 * MiB;
constexpr size_t WS_KT = 48 * MiB, WS_HB = 48 * MiB  , WS_MERGED = 48 * MiB, WS_F = 48 * MiB;
constexpr size_t WS_NQ = 80 * MiB, WS_H2 = 80 * MiB;
constexpr size_t WS_NK = 112 * MiB, WS_NV = 144 * MiB, WS_VT = 112 * MiB, WS_SG = 112 * MiB, WS_ACT = 112 * MiB;
constexpr size_t WS_SCR = 240 * MiB;
constexpr size_t WS_HA = 176 * MiB  , WS_O = 176 * MiB, WS_OUTMIX = 176 * MiB, WS_END = 256 * MiB;

__device__ __forceinline__ float wave_sum(float v) {
#pragma unroll
    for (int o = 1; o < 64; o <<= 1) v += __shfl_xor(v, o);
    return v;
}
__device__ __forceinline__ float bf2f(unsigned short b) { return __uint_as_float((unsigned)b << 16); }
__device__ __forceinline__ unsigned pk2(float lo, float hi) { return pg8::cvt_pk_bf16(lo, hi); }
__device__ __forceinline__ float rdlane(float v, int l) { return __int_as_float(__builtin_amdgcn_readlane(__float_as_int(v), l)); }

__device__ __forceinline__ void transpose_item(const float* W, int K, int N, bf16* WT, int k0, int n0, int drow0, LAS float* scr, int lane) {
#pragma unroll 8
    for (int i = 0; i < 32; ++i) { const int kk = 2 * i + (lane >> 5); scr[kk * 33 + (lane & 31)] = W[(size_t)(k0 + kk) * N + n0 + (lane & 31)]; }
    asm volatile("s_waitcnt lgkmcnt(0)" ::: "memory");
    const int c = lane & 7;
#pragma unroll
    for (int j = 0; j < 4; ++j) { const int n = (lane >> 3) + 8 * j; const LAS float* s = scr + (8 * c) * 33 + n;
        u32x4 o; o.x = pk2(s[0 * 33], s[1 * 33]); o.y = pk2(s[2 * 33], s[3 * 33]); o.z = pk2(s[4 * 33], s[5 * 33]); o.w = pk2(s[6 * 33], s[7 * 33]);
        *(u32x4*)(WT + (size_t)(drow0 + n) * K + k0 + 8 * c) = o; }
    asm volatile("s_waitcnt lgkmcnt(0)" ::: "memory");
}

#define RLX_AGENT __ATOMIC_RELAXED, __HIP_MEMORY_SCOPE_AGENT
#define XB_TMO      128
#define XB_XCNT(j)  (256  + 64 * (j))
#define XB_XSUB(j)  (1280 + 64 * (j))
#define XB_XGEN(j)  (2304 + 64 * (j))
#define XB_TOP      3328
#define XB_TOPGEN   3392
#define XCD_BAR_WORDS 3456
#define XB_SPIN_CAP (1u << 18)

__device__ __forceinline__ unsigned xb_ld(unsigned* p)              { return __hip_atomic_load(p, __ATOMIC_RELAXED, __HIP_MEMORY_SCOPE_AGENT); }
__device__ __forceinline__ unsigned xb_add(unsigned* p, unsigned v) { return __hip_atomic_fetch_add(p, v, __ATOMIC_RELAXED, __HIP_MEMORY_SCOPE_AGENT); }
__device__ __forceinline__ unsigned xb_xcc_id() { return (unsigned)__builtin_amdgcn_s_getreg((3 << 11) | 20) & 0xFu; }
#define XB_SPIN(cond, bar) do { unsigned _sp = 0; while (cond) { __builtin_amdgcn_s_sleep(1); \
    if ((++_sp & 255u) == 0u) { if (xb_ld(&(bar)[XB_TMO])) break; if (_sp > XB_SPIN_CAP) { atomicAdd(&(bar)[XB_TMO], 1u); break; } } } } while (0)

struct XcdBarrier {
    unsigned* bar; unsigned x;
    volatile LAS unsigned* st;
};

__device__ __forceinline__ XcdBarrier xcd_barrier_post(unsigned* bar, volatile LAS unsigned* st) {
    XcdBarrier b; b.bar = bar; b.x = xb_xcc_id(); b.st = st;
    if (threadIdx.x == 0) (void)xb_add(&bar[XB_XCNT(b.x)], 1u);
    return b;
}
__device__ __forceinline__ void xcd_barrier_complete(unsigned* bar, unsigned x, unsigned& nloc, unsigned& nx) {
    const unsigned G = gridDim.x * gridDim.y * gridDim.z;
    unsigned sum, cnt, mine, sp = 0u;
    for (;;) {
        sum = 0u; cnt = 0u; mine = 0u;
#pragma unroll
        for (unsigned j = 0; j < 16; ++j) { const unsigned c = xb_ld(&bar[XB_XCNT(j)]); sum += c; cnt += (c > 0u) ? 1u : 0u; mine = (j == x) ? c : mine; }
        if (sum == G) break;
        __builtin_amdgcn_s_sleep(1);
        if ((++sp & 255u) == 0u) { if (xb_ld(&bar[XB_TMO])) break; if (sp > XB_SPIN_CAP) { atomicAdd(&bar[XB_TMO], 1u); break; } }
    }
    nloc = mine > 0u ? mine : 1u; nx = cnt > 0u ? cnt : 1u;
}

__device__ __forceinline__ void xcd_barrier(const XcdBarrier& b) {
    asm volatile("s_waitcnt vmcnt(0)" ::: "memory");
    __syncthreads();
    if (threadIdx.x == 0) {
        unsigned* bar = b.bar;
        __builtin_amdgcn_s_waitcnt(0);
        unsigned nloc = b.st[0], nx = b.st[1];
        if (nloc == 0u) { xcd_barrier_complete(bar, b.x, nloc, nx); b.st[0] = nloc; b.st[1] = nx; }
        const unsigned old = xb_add(&bar[XB_XSUB(b.x)], 1u);
        const unsigned gen = old / nloc;
        if (old + 1u == (gen + 1u) * nloc) {
            __builtin_amdgcn_fence(__ATOMIC_RELEASE, "agent");
            asm volatile("s_waitcnt vmcnt(0)" ::: "memory");
            const unsigned og = xb_add(&bar[XB_TOP], 1u);
            const unsigned tg = og / nx;
            if (og + 1u == (tg + 1u) * nx) xb_add(&bar[XB_TOPGEN], 1u);
            else XB_SPIN(xb_ld(&bar[XB_TOPGEN]) == tg, bar);
            __builtin_amdgcn_fence(__ATOMIC_ACQUIRE, "agent");
            xb_add(&bar[XB_XGEN(b.x)], 1u);
            asm volatile("s_waitcnt vmcnt(0)" ::: "memory");
        } else {
            XB_SPIN(xb_ld(&bar[XB_XGEN(b.x)]) == gen, bar);
            __builtin_amdgcn_fence(__ATOMIC_ACQUIRE, "agent");
            asm volatile("s_waitcnt vmcnt(0)" ::: "memory");
        }
    }
    __syncthreads();
}

constexpr int CW_BAR = 4096;
constexpr int RING_BYTES = 131072, MISC_OFF = RING_BYTES + 320;
constexpr size_t CTL_ZERO_BYTES = 64 * 1024;
#ifndef ONE_LAUNCH
#define ONE_LAUNCH 1
#endif
typedef float f32x16 __attribute__((ext_vector_type(16)));
typedef float f32x2 __attribute__((ext_vector_type(2)));
typedef short bf16x8 __attribute__((ext_vector_type(8)));
typedef short s16x2 __attribute__((ext_vector_type(2)));
typedef __bf16 bf16x2_t __attribute__((ext_vector_type(2)));
typedef unsigned long long u64x2 __attribute__((ext_vector_type(2)));
#define MFMA32(a, b, c) __builtin_amdgcn_mfma_f32_32x32x16_bf16((a), (b), (c), 0, 0, 0)
__device__ __forceinline__ void atomic_add_bf16x2(bf16* p, float a, float b) {
    f32x2 v = {a, b}; bf16x2_t w = __builtin_convertvector(v, bf16x2_t);
    __builtin_amdgcn_global_atomic_fadd_v2bf16((__attribute__((address_space(1))) s16x2*)p, __builtin_bit_cast(s16x2, w));
}
__device__ __forceinline__ void store_b64_uncounted(void* p, u32x2 v) { asm volatile("global_store_dwordx2 %0, %1, off\n\ts_nop 1" :: "v"(p), "v"(v) : "memory"); }
__device__ __forceinline__ float log2_sigmoid(float x) { return -log1pf(expf(-x)) * 1.4426950408889634f; }

__device__ __forceinline__ void h_rows(const float* xin, const float* MOD, const float* gain, bf16* Hout, int seq0, int seqlen, int gw, int NGW, int lane) {
    for (int t = gw; t < TP; t += NGW) { const float* mod = MOD + (size_t)(seq0 + t / seqlen) * 6144;
        const f32x4* xr = (const f32x4*)(xin + (size_t)t * D) + lane; f32x4 v[4]; float ss = 0.f;
#pragma unroll
        for (int j = 0; j < 4; ++j) { v[j] = xr[64 * j]; ss += (v[j].x * v[j].x + v[j].y * v[j].y) + (v[j].z * v[j].z + v[j].w * v[j].w); }
        const float rstd = 1.0f / sqrtf(wave_sum(ss) * (1.f / D) + EPS);
        u32x2* o8 = (u32x2*)(Hout + (size_t)t * D) + lane;
#pragma unroll
        for (int j = 0; j < 4; ++j) { const int c = 4 * lane + 256 * j; const f32x4 g = *(const f32x4*)(gain + c), sh = *(const f32x4*)(mod + c), sc = *(const f32x4*)(mod + 1024 + c);
            const f32x4 h = v[j] * rstd * g * (sc + 1.0f) + sh; u32x2 w; w.x = pk2(h.x, h.y); w.y = pk2(h.z, h.w); o8[64 * j] = w; }
    }
}

__device__ __forceinline__ bf16x8 bload16(__amdgpu_buffer_rsrc_t rs, unsigned voff, unsigned soff) { return __builtin_bit_cast(bf16x8, __builtin_amdgcn_raw_buffer_load_b128(rs, voff, soff, 0)); }
__device__ __forceinline__ unsigned long long bload8(__amdgpu_buffer_rsrc_t rs, unsigned voff, unsigned soff) { return __builtin_bit_cast(unsigned long long, __builtin_amdgcn_raw_buffer_load_b64(rs, voff, soff, 0)); }
#define RSRC(ptr, bytes) __builtin_amdgcn_make_buffer_rsrc((void*)(ptr), (short)0, (int)(bytes), 0x00020000)
__device__ __forceinline__ void ret_intra(const bf16* QB, const bf16* KB, const bf16* VT, bf16* Ob, const float* decay_logit, int lane, int wave, int G) {
    const int r32 = lane & 31, hh = lane >> 5, qt = wave >> 1, dh = wave & 1, qi = 32 * qt + r32;
    const __amdgpu_buffer_rsrc_t rsQ = RSRC(QB, 32u << 20), rsK = RSRC(KB, 32u << 20), rsV = RSRC(VT, 64u << 20);
    const unsigned vlane = (unsigned)lane * 16u, vv = (unsigned)r32 * 16u + (unsigned)hh * 8u;
    for (int un = blockIdx.x; un < 512; un += G) { const int cg = un >> 2, h = un & 3;
        const float L2f = log2_sigmoid(decay_logit[h]), L2b = log2_sigmoid(decay_logit[4 + h]);
        f32x16 P[4];
#pragma unroll
        for (int kt = 0; kt < 4; ++kt)
#pragma unroll
            for (int g = 0; g < 16; ++g) P[kt][g] = 0.f;
        const unsigned sq = (unsigned)((h * 512 + cg * 4 + qt) * 16) * 1024u, sk = (unsigned)((h * 512 + cg * 4) * 16) * 1024u;
        bf16x8 qa[2], ka[2][4], qb[2], kb[2][4];
#define RI_LOAD(QX, KX, S0_) do { _Pragma("unroll") for (int j = 0; j < 2; ++j) { QX[j] = bload16(rsQ, vlane, sq + ((S0_) + j) * 1024u); \
        _Pragma("unroll") for (int kt = 0; kt < 4; ++kt) KX[j][kt] = bload16(rsK, vlane, sk + (unsigned)(kt * 16 + (S0_) + j) * 1024u); } } while (0)
#define RI_MMA(QX, KX) do { _Pragma("unroll") for (int j = 0; j < 2; ++j) _Pragma("unroll") for (int kt = 0; kt < 4; ++kt) P[kt] = MFMA32(KX[j][kt], QX[j], P[kt]); } while (0)
        RI_LOAD(qa, ka, 0);
#pragma unroll 1
        for (int sb = 0; sb < 8; sb += 2) { RI_LOAD(qb, kb, 2 * sb + 2); RI_MMA(qa, ka); RI_LOAD(qa, ka, (sb + 2 < 8) ? 2 * sb + 4 : 0); RI_MMA(qb, kb); }
#undef RI_LOAD
#undef RI_MMA
        bf16x8 pb[4][2];
        int qio = qi; asm volatile("" : "+v"(qio));
#pragma unroll
        for (int kt = 0; kt < 4; ++kt) {
#pragma unroll
            for (int g = 0; g < 16; ++g) { const int kj = 32 * kt + (g & 3) + 8 * (g >> 2) + 4 * hh; const int d = qio - kj;
                P[kt][g] *= __builtin_amdgcn_exp2f(d >= 0 ? (float)d * L2f : (float)(-d) * L2b); }
#pragma unroll
            for (int s2 = 0; s2 < 2; ++s2) { u32x4 w; w.x = pk2(P[kt][8 * s2 + 0], P[kt][8 * s2 + 1]); w.y = pk2(P[kt][8 * s2 + 2], P[kt][8 * s2 + 3]);
                w.z = pk2(P[kt][8 * s2 + 4], P[kt][8 * s2 + 5]); w.w = pk2(P[kt][8 * s2 + 6], P[kt][8 * s2 + 7]); pb[kt][s2] = __builtin_bit_cast(bf16x8, w); }
        }
        const size_t tok = (size_t)cg * 128 + qi;
        u64x2 va[8], vb[8];
#define RI_LOADV(VX, DVT) do { const unsigned sv_ = (unsigned)(((h * 128 + cg) * 16 + 8 * dh + (DVT)) * 8) * 1024u; \
        _Pragma("unroll") for (int sb = 0; sb < 8; ++sb) { VX[sb].x = bload8(rsV, vv, sv_ + sb * 1024u); VX[sb].y = bload8(rsV, vv, sv_ + sb * 1024u + 512u); } } while (0)
#define RI_PV(VX, DVT) do { f32x16 o; _Pragma("unroll") for (int g = 0; g < 16; ++g) o[g] = 0.f; \
        _Pragma("unroll") for (int sb = 0; sb < 8; ++sb) o = MFMA32(__builtin_bit_cast(bf16x8, VX[sb]), pb[sb >> 1][sb & 1], o); \
        bf16* op = Ob + tok * 2048 + 512 * h + 32 * (8 * dh + (DVT)) + 4 * hh; \
        _Pragma("unroll") for (int g4 = 0; g4 < 4; ++g4) { u32x2 w; w.x = pk2(o[4 * g4], o[4 * g4 + 1]); w.y = pk2(o[4 * g4 + 2], o[4 * g4 + 3]); *(u32x2*)(op + 8 * g4) = w; } } while (0)
        RI_LOADV(va, 0);
#pragma unroll 1
        for (int dvt = 0; dvt < 8; dvt += 2) { RI_LOADV(vb, dvt + 1); RI_PV(va, dvt); RI_LOADV(va, (dvt + 2 < 8) ? dvt + 2 : 0); RI_PV(vb, dvt + 1); }
#undef RI_LOADV
#undef RI_PV
    }
}

template <bool FULL>
__device__ __forceinline__ void ret_scan(LAS unsigned char* lds, const bf16* QB, const bf16* KT, const bf16* VT, bf16* Ob, float* SCR, const float* decay_logit, int nseq, int seqlen, int tid, int lane, int wave, int G) {
    constexpr int ST_STRIDE = 528, ST_DIR = 32 * ST_STRIDE, ST_BYTES = 2 * ST_DIR, VL_OFF = 2 * ST_BYTES, VL_BYTES = 16384, ZT_OFF = VL_OFF + 2 * VL_BYTES, SEGL = 32;
    const int nc = seqlen >> 7, nseg = nc / SEGL, r32 = lane & 31, hh = lane >> 5, dir = wave >> 2, tt = wave & 3;
    const __amdgpu_buffer_rsrc_t rsQ = RSRC(QB, 32u << 20), rsK = RSRC(KT, 32u << 20), rsV = RSRC(VT, 64u << 20), rsO = RSRC(Ob, 64u << 20);
    const unsigned vlane = (unsigned)lane * 16u, vtid = (unsigned)(tid & 255) * 16u;
    for (int rep = 0; rep < 1; ++rep) { if (G != 256) break;
        const int slot = blockIdx.x >> 3, pr = (blockIdx.x & 7) + 8 * (slot >> 4), sl = slot & 15, grp = pr / nseg, seg = pr - grp * nseg, sq = grp >> 2, h = grp & 3;
        const float L2f = log2_sigmoid(decay_logit[h]), L2b = log2_sigmoid(decay_logit[4 + h]);
        const float gCf = __builtin_amdgcn_exp2f(128.f * L2f), gCb = __builtin_amdgcn_exp2f(128.f * L2b);
        LAS float* ZT = (LAS float*)(lds + ZT_OFF);
        if (tid < 256) ZT[tid] = (tid < 128) ? __builtin_amdgcn_exp2f(L2f * (float)(127 - tid)) : __builtin_amdgcn_exp2f(L2b * (float)(tid - 128));
        const int qi = 32 * tt + r32; const float xi = (dir == 0) ? __builtin_amdgcn_exp2f(L2f * (float)(qi + 1)) : __builtin_amdgcn_exp2f(L2b * (float)(128 - qi));
        const unsigned vO = (unsigned)qi * 4096u + 8u * (unsigned)hh;
        const int cbase = sq * nc + seg * SEGL;
        f32x16 S0, S1;
#pragma unroll
        for (int g = 0; g < 16; ++g) { S0[g] = 0.f; S1[g] = 0.f; }
        if constexpr (FULL) {
            for (int j = 0; j < nseg; ++j) { if (j == seg) continue;
                const float* src = SCR + ((size_t)((grp * nseg + j) * 16 + sl) * 2 + (j < seg ? 0 : 1)) * 8192 + wave * 1024 + lane;
                const float w = (j < seg) ? __builtin_amdgcn_exp2f(L2f * (float)(128 * SEGL * (seg - 1 - j))) : __builtin_amdgcn_exp2f(L2b * (float)(128 * SEGL * (j - seg - 1)));
                if (j < seg) {
#pragma unroll
                    for (int g = 0; g < 16; ++g) S0[g] += w * src[g * 64];
                } else {
#pragma unroll
                    for (int g = 0; g < 16; ++g) S1[g] += w * src[g * 64];
                } }
            { LAS unsigned char* wb = lds + r32 * ST_STRIDE + 64 * wave + 8 * hh;
#pragma unroll
              for (int g4 = 0; g4 < 4; ++g4) { u32x2 w; w.x = pk2(S0[4 * g4], S0[4 * g4 + 1]); w.y = pk2(S0[4 * g4 + 2], S0[4 * g4 + 3]); *(LAS u32x2*)(wb + 16 * g4) = w;
                  w.x = pk2(S1[4 * g4], S1[4 * g4 + 1]); w.y = pk2(S1[4 * g4 + 2], S1[4 * g4 + 3]); *(LAS u32x2*)(wb + ST_DIR + 16 * g4) = w; } }
        }
        bf16x8 Qf[16], Kf[8]; u32x4 Vr[2];
        int cf = cbase, cb = cbase + SEGL - 1;
        { const int cq = dir == 0 ? cf : cb;
          if constexpr (FULL) { const unsigned so = (unsigned)((h * 512 + cq * 4 + tt) * 16) * 1024u;
#pragma unroll
            for (int s = 0; s < 16; ++s) Qf[s] = bload16(rsQ, vlane, so + s * 1024u); }
          const unsigned sk = (unsigned)(((h * 128 + cf) * 8 + wave) * 8) * 1024u;
#pragma unroll
          for (int s = 0; s < 8; ++s) Kf[s] = bload16(rsK, vlane, sk + s * 1024u);
          const unsigned sv = (unsigned)((h * 128 + cq) * 16 + sl) * 8192u;
#pragma unroll
          for (int k = 0; k < 2; ++k) Vr[k] = __builtin_amdgcn_raw_buffer_load_b128(rsV, vtid, sv + k * 4096u, 0); }
        __syncthreads();
        for (int i = 0; i < SEGL; ++i) { const int buf = i & 1; const int in = (i + 1 < SEGL) ? i + 1 : i; const int cfn = cbase + in, cbn = cbase + SEGL - 1 - in;
            const int cq = dir == 0 ? cf : cb, cqn = dir == 0 ? cfn : cbn;
#pragma unroll
            for (int k = 0; k < 2; ++k) { const int u = (tid & 255) + 256 * k, j0 = 16 * ((u >> 6) & 7) + 8 * ((u >> 5) & 1); float f[8]; pg8::unpack8(Vr[k], f);
                const f32x4 z0 = *(const LAS f32x4*)(ZT + dir * 128 + j0), z1 = *(const LAS f32x4*)(ZT + dir * 128 + j0 + 4);
                f[0] *= z0.x; f[1] *= z0.y; f[2] *= z0.z; f[3] *= z0.w; f[4] *= z1.x; f[5] *= z1.y; f[6] *= z1.z; f[7] *= z1.w;
                *(LAS u32x4*)(lds + VL_OFF + buf * VL_BYTES + dir * 8192 + u * 16) = pg8::pack8(f); }
            if constexpr (FULL) {
                const int dmid = SEGL - 1 - 2 * i; if (dmid <= 5 && dmid >= -5) asm volatile("s_waitcnt vmcnt(0)" ::: "memory"); }
            asm volatile("s_waitcnt lgkmcnt(0)\n\ts_barrier" ::: "memory");
            { const unsigned sv = (unsigned)((h * 128 + cqn) * 16 + sl) * 8192u;
#pragma unroll
              for (int k = 0; k < 2; ++k) Vr[k] = __builtin_amdgcn_raw_buffer_load_b128(rsV, vtid, sv + k * 4096u, 0); }
            u32x2 Or[4];
            if constexpr (FULL) { const unsigned sO = (unsigned)(cq * 128) * 4096u + (unsigned)(512 * h + 32 * sl) * 2u;
#pragma unroll
              for (int g4 = 0; g4 < 4; ++g4) Or[g4] = __builtin_amdgcn_raw_buffer_load_b64(rsO, vO, sO + 16u * g4, 0); }
            const LAS unsigned char* vlb = lds + VL_OFF + buf * VL_BYTES + lane * 16;
#pragma unroll
            for (int g = 0; g < 16; ++g) S0[g] *= gCf;
            { bf16x8 fr[8];
#pragma unroll
              for (int s = 0; s < 8; ++s) fr[s] = *(const LAS bf16x8*)(vlb + s * 1024);
#pragma unroll
              for (int s = 0; s < 8; ++s) S0 = MFMA32(Kf[s], fr[s], S0); }
            { const unsigned sk = (unsigned)(((h * 128 + cb) * 8 + wave) * 8) * 1024u;
#pragma unroll
              for (int s = 0; s < 8; ++s) Kf[s] = bload16(rsK, vlane, sk + s * 1024u); }
            if constexpr (FULL) {
            f32x16 cr;
#pragma unroll
            for (int g = 0; g < 16; ++g) cr[g] = 0.f;
            { const LAS unsigned char* stb = lds + buf * ST_BYTES + dir * ST_DIR + r32 * ST_STRIDE + hh * 16;
              f32x16 cr2;
#pragma unroll
              for (int g = 0; g < 16; ++g) cr2[g] = 0.f;
#pragma unroll
              for (int s0 = 0; s0 < 16; s0 += 8) { bf16x8 fr[8];
#pragma unroll
                  for (int s = 0; s < 8; ++s) fr[s] = *(const LAS bf16x8*)(stb + (s0 + s) * 32);
#pragma unroll
                  for (int s = 0; s < 8; s += 2) { cr = MFMA32(fr[s], Qf[s0 + s], cr); cr2 = MFMA32(fr[s + 1], Qf[s0 + s + 1], cr2); } }
#pragma unroll
              for (int g = 0; g < 16; ++g) cr[g] += cr2[g]; }
            { const unsigned so = (unsigned)((h * 512 + cqn * 4 + tt) * 16) * 1024u;
#pragma unroll
              for (int s = 0; s < 16; ++s) Qf[s] = bload16(rsQ, vlane, so + s * 1024u); }
            { bf16* op = Ob + ((size_t)cq * 128 + qi) * 2048 + 512 * h + 32 * sl + 4 * hh;
#pragma unroll
              for (int g4 = 0; g4 < 4; ++g4) { u32x2 w;
                w.x = pk2(pg8::bflo(Or[g4].x) + cr[4 * g4] * xi, pg8::bfhi(Or[g4].x) + cr[4 * g4 + 1] * xi); w.y = pk2(pg8::bflo(Or[g4].y) + cr[4 * g4 + 2] * xi, pg8::bfhi(Or[g4].y) + cr[4 * g4 + 3] * xi);
                store_b64_uncounted(op + 8 * g4, w); } }
            }
#pragma unroll
            for (int g = 0; g < 16; ++g) S1[g] *= gCb;
            { bf16x8 fr[8];
#pragma unroll
              for (int s = 0; s < 8; ++s) fr[s] = *(const LAS bf16x8*)(vlb + 8192 + s * 1024);
#pragma unroll
              for (int s = 0; s < 8; ++s) S1 = MFMA32(Kf[s], fr[s], S1); }
            { const unsigned sk = (unsigned)(((h * 128 + cfn) * 8 + wave) * 8) * 1024u;
#pragma unroll
              for (int s = 0; s < 8; ++s) Kf[s] = bload16(rsK, vlane, sk + s * 1024u); }
            if constexpr (FULL) { LAS unsigned char* wb = lds + (buf ^ 1) * ST_BYTES + r32 * ST_STRIDE + 64 * wave + 8 * hh;
#pragma unroll
              for (int g4 = 0; g4 < 4; ++g4) { u32x2 w; w.x = pk2(S0[4 * g4], S0[4 * g4 + 1]); w.y = pk2(S0[4 * g4 + 2], S0[4 * g4 + 3]); *(LAS u32x2*)(wb + 16 * g4) = w;
                  w.x = pk2(S1[4 * g4], S1[4 * g4 + 1]); w.y = pk2(S1[4 * g4 + 2], S1[4 * g4 + 3]); *(LAS u32x2*)(wb + ST_DIR + 16 * g4) = w; } }
            cf = cfn; cb = cbn;
        }
        if constexpr (!FULL) {
            float* dst = SCR + ((size_t)((grp * nseg + seg) * 16 + sl) * 2) * 8192 + wave * 1024 + lane;
#pragma unroll
            for (int g = 0; g < 16; ++g) { dst[g * 64] = S0[g]; dst[8192 + g * 64] = S1[g]; }
        }
        asm volatile("s_waitcnt vmcnt(0)" ::: "memory");
        __syncthreads();
    }
}

typedef float f32x4_ __attribute__((ext_vector_type(4)));
#define MFMA16(a, b, c) __builtin_amdgcn_mfma_f32_16x16x32_bf16((a), (b), (c), 0, 0, 0)
__device__ __forceinline__ void na_mfma(LAS unsigned char* lds, bf16* NQ, const bf16* NKB, const bf16* NVT, const float* rpb, int seqlen, int tid, int lane, int wave, int G) {
    LAS float* RP = (LAS float*)lds;
    for (int i = tid; i < 16 * 15 * 31; i += NTHREADS) RP[i] = rpb[i] * 1.4426950408889634f;
    __syncthreads();
    const int rows = seqlen >> 6, r16 = lane & 15, q4 = lane >> 4, g = wave & 3;
    const int c0 = (g == 0) ? 0 : ((g == 1) ? 8 : ((g == 2) ? 24 : 32)), c = 16 * g + r16;
    int cs = c - 8; cs = cs < 0 ? 0 : cs; cs = cs > 48 ? 48 : cs;
    constexpr unsigned TB = TP / 8;
    const __amdgpu_buffer_rsrc_t rsQ = RSRC(NQ, 32u << 20), rsK = RSRC(NKB, 32u << 20), rsV = RSRC(NVT, 32u << 20);
    const unsigned vQ = (unsigned)r16 * 2048u + (unsigned)q4 * 16u, vK = (unsigned)(((r16 >> 3) * 32 + q4 * 8 + (r16 & 7)) * 16), vV = (unsigned)((q4 >> 1) * 1024 + r16 * 16 + (q4 & 1) * 8);
    for (int un = blockIdx.x; un < 256 * 8; un += G) { const int R = un >> 3, h = (un & 7) * 2 + (wave >> 2);
        int cc = c; asm volatile("" : "+v"(cc));
        const int r = R % rows, Rb = R - r; int rs = r - 4; rs = rs < 0 ? 0 : rs; rs = rs > rows - 8 ? rows - 8 : rs;
        const unsigned sQ = (unsigned)(R * 64 + 16 * g) * 2048u + (unsigned)h * 128u;
        const unsigned tokb = (unsigned)((Rb + rs) * 64 + c0);
        bf16x8 qf[2];
#pragma unroll
        for (int ks = 0; ks < 2; ++ks) qf[ks] = bload16(rsQ, vQ, sQ + ks * 64u);
        f32x4_ S[16];
        bf16x8 ka[2][2][2], kb[2][2][2];
#define NA_LOADK(KX, KR0) do { _Pragma("unroll") for (int j = 0; j < 2; ++j) _Pragma("unroll") for (int ch = 0; ch < 2; ++ch) _Pragma("unroll") for (int ks = 0; ks < 2; ++ks) \
        KX[j][ch][ks] = bload16(rsK, vK, (((unsigned)(h * 2 + ks) * TB + ((tokb + (unsigned)((KR0) + j) * 64u + 16u * ch) >> 3)) * 512u)); } while (0)
#define NA_QK(KX, KR0) do { _Pragma("unroll") for (int j = 0; j < 2; ++j) _Pragma("unroll") for (int ch = 0; ch < 2; ++ch) { f32x4_ a_ = {0.f, 0.f, 0.f, 0.f}; \
        a_ = MFMA16(KX[j][ch][0], qf[0], a_); a_ = MFMA16(KX[j][ch][1], qf[1], a_); S[2 * ((KR0) + j) + ch] = a_; } } while (0)
        NA_LOADK(ka, 0); NA_LOADK(kb, 2); NA_QK(ka, 0); NA_LOADK(ka, 4); NA_QK(kb, 2); NA_LOADK(kb, 6); NA_QK(ka, 4); NA_QK(kb, 6);
#undef NA_LOADK
#undef NA_QK
        u64x2 va[2][4], vb[2][4];
#define NA_LOADV(VX, KR0) do { _Pragma("unroll") for (int j = 0; j < 2; ++j) { const unsigned sv_ = ((unsigned)h * TB + ((tokb + (unsigned)((KR0) + j) * 64u) >> 3)) * 1024u; \
        _Pragma("unroll") for (int dt = 0; dt < 4; ++dt) { VX[j][dt].x = bload8(rsV, vV, sv_ + dt * 256u); VX[j][dt].y = bload8(rsV, vV, sv_ + 2048u + dt * 256u); } } } while (0)
        NA_LOADV(va, 0); NA_LOADV(vb, 2);
        float mx = -1e30f;
#pragma unroll
        for (int kr = 0; kr < 8; ++kr) { const LAS float* brow = RP + (h * 15 + (rs + kr - r + 7)) * 31 + 15 - cc;
#pragma unroll
            for (int ch = 0; ch < 2; ++ch)
#pragma unroll
                for (int e = 0; e < 4; ++e) { const int kc = c0 + 16 * ch + 4 * q4 + e; const bool ok = (kc >= cs) && (kc < cs + 16);
                    const float sv = ok ? S[2 * kr + ch][e] * 1.4426950408889634f + brow[ok ? kc : cc] : -1e30f; S[2 * kr + ch][e] = sv; mx = fmaxf(mx, sv); } }
        mx = fmaxf(mx, __shfl_xor(mx, 16)); mx = fmaxf(mx, __shfl_xor(mx, 32));
        float l = 0.f;
#pragma unroll
        for (int t = 0; t < 16; ++t)
#pragma unroll
            for (int e = 0; e < 4; ++e) { const float p = __builtin_amdgcn_exp2f(S[t][e] - mx); S[t][e] = p; l += p; }
        l += __shfl_xor(l, 16); l += __shfl_xor(l, 32);
        const float il = 1.0f / l;
        f32x4_ O[4];
#pragma unroll
        for (int dt = 0; dt < 4; ++dt) O[dt] = (f32x4_){0.f, 0.f, 0.f, 0.f};
#define NA_PV(VX, KR0) do { _Pragma("unroll") for (int j = 0; j < 2; ++j) { const int kr_ = (KR0) + j; u32x4 w_; w_.x = pk2(S[2 * kr_][0], S[2 * kr_][1]); w_.y = pk2(S[2 * kr_][2], S[2 * kr_][3]); \
        w_.z = pk2(S[2 * kr_ + 1][0], S[2 * kr_ + 1][1]); w_.w = pk2(S[2 * kr_ + 1][2], S[2 * kr_ + 1][3]); const bf16x8 pf_ = __builtin_bit_cast(bf16x8, w_); \
        _Pragma("unroll") for (int dt = 0; dt < 4; ++dt) O[dt] = MFMA16(__builtin_bit_cast(bf16x8, VX[j][dt]), pf_, O[dt]); } } while (0)
        NA_PV(va, 0); NA_LOADV(va, 4); NA_PV(vb, 2); NA_LOADV(vb, 6); NA_PV(va, 4); NA_PV(vb, 6);
#undef NA_LOADV
#undef NA_PV
        bf16* yp = NQ + ((size_t)R * 64 + cc) * 1024 + 64 * h + 4 * q4;
#pragma unroll
        for (int dt = 0; dt < 4; ++dt) { u32x2 w; w.x = pk2(O[dt][0] * il, O[dt][1] * il); w.y = pk2(O[dt][2] * il, O[dt][3] * il); *(u32x2*)(yp + 16 * dt) = w; }
    }
    __syncthreads();
}

struct Args { const float* in[19]; float* out; unsigned char* ws; int ph_lo, ph_hi; };

__global__ void __launch_bounds__(NTHREADS, 2) fwd(Args args) {
    extern __shared__ __attribute__((aligned(16))) unsigned char lds_raw[];
    LAS unsigned char* lds = (LAS unsigned char*)lds_raw;
    for (int u = threadIdx.x; u < (LDS_BYTES - RING_BYTES) / 4; u += NTHREADS) ((LAS unsigned*)(lds + RING_BYTES))[u] = 0u;
    __syncthreads();
    if (args.ph_hi - args.ph_lo > 1) (void)xcd_barrier_post((unsigned*)(args.ws + WS_CTL) + CW_BAR, (volatile LAS unsigned*)(lds + MISC_OFF) + 8);
    for (int ph = args.ph_lo; ph < args.ph_hi; ++ph) {
#ifdef REP_MASK
    const int nrep_ = (ph >= 2 && ((REP_MASK >> ((ph - 2) % NSTEP)) & 1)) ? 2 : 1;
#else
    const int nrep_ = 1;
#endif
    for (int rep_ = 0; rep_ < nrep_; ++rep_) {
    int tid = threadIdx.x; asm volatile("" : "+v"(tid));
    const int lane = tid & 63, wave = __builtin_amdgcn_readfirstlane(tid >> 6);
    const int G = gridDim.x, gw = blockIdx.x * NWAVES + wave, NGW = G * NWAVES;
    size_t zoff = 0; asm volatile("" : "+s"(zoff)); unsigned char* ws = args.ws + zoff;
    const float* x_prompt = args.in[0]; const float* x_sample = args.in[1]; const float* c_prompt = args.in[2]; const float* c_sample = args.in[3];
    const float* w_mod = args.in[4]; const float* b_mod = args.in[5]; const float* g_pre_mix = args.in[6]; const float* w_in = args.in[7];
    const float* rpb = args.in[8]; const float* decay_logit = args.in[9]; const float* ret_gn = args.in[10]; const float* w_up_na = args.in[11];
    const float* w_up_ret = args.in[12]; const float* w_out = args.in[13]; const float* g_post_mix = args.in[14]; const float* g_pre_ffn = args.in[15];
    const float* w_ffn_in = args.in[16]; const float* w_ffn_out = args.in[17]; const float* g_post_ffn = args.in[18];
    float* MODP = (float*)(ws + WS_MODP); float* MOD = (float*)(ws + WS_MOD);
    bf16* WIN = (bf16*)(ws + WS_WIN); bf16* WNA = (bf16*)(ws + WS_WNA); bf16* WRET = (bf16*)(ws + WS_WRET); bf16* WOUT = (bf16*)(ws + WS_WOUT);
    bf16* WFI = (bf16*)(ws + WS_WFI); bf16* WFO = (bf16*)(ws + WS_WFO);
    bf16* HA = (bf16*)(ws + WS_HA); bf16* HB = (bf16*)(ws + WS_HB); bf16* NQ = (bf16*)(ws + WS_NQ); bf16* NK = (bf16*)(ws + WS_NK); bf16* NV = (bf16*)(ws + WS_NV);
    bf16* KT = (bf16*)(ws + WS_KT); bf16* VT = (bf16*)(ws + WS_VT);
    bf16* Ob = (bf16*)(ws + WS_O); bf16* SG = (bf16*)(ws + WS_SG); bf16* MERGED = (bf16*)(ws + WS_MERGED);
    float* OUTMIX = (float*)(ws + WS_OUTMIX); bf16* H2 = (bf16*)(ws + WS_H2); bf16* ACT = (bf16*)(ws + WS_ACT); float* Fb = (float*)(ws + WS_F);
        if (ph == 0 && !(DIS & 1)) {
            LAS float* scr = (LAS float*)(lds + wave * 16384);
            constexpr int I_IN = 16 * 352, I_NA = 16 * 32, I_RET = 32 * 32, I_OUT = 16 * 32, I_FI = 16 * 176, I_FO = 44 * 32, I_MOD = 96 * 8;
            constexpr int NITEMS = I_IN + I_NA + I_RET + I_OUT + I_FI + I_FO + I_MOD;
            for (int it = gw; it < NITEMS; it += NGW) {
                int r = it;
                if (r < I_IN) { const int nb = r % 352, kb = r / 352; transpose_item(w_in, 1024, 11264, WIN, 64 * kb, 32 * nb, 32 * nb, scr, lane); continue; } r -= I_IN;
                if (r < I_NA) { const int nb = r % 32, kb = r / 32; transpose_item(w_up_na, 1024, 1024, WNA, 64 * kb, 32 * nb, 32 * nb, scr, lane); continue; } r -= I_NA;
                if (r < I_RET) { const int nb = r % 32, kb = r / 32; transpose_item(w_up_ret, 2048, 1024, WRET, 64 * kb, 32 * nb, 32 * nb, scr, lane); continue; } r -= I_RET;
                if (r < I_OUT) { const int nb = r % 32, kb = r / 32; transpose_item(w_out, 1024, 1024, WOUT, 64 * kb, 32 * nb, 32 * nb, scr, lane); continue; } r -= I_OUT;
                if (r < I_FI) { const int nb = r % 176, kb = r / 176; const int n0 = 32 * nb; const int j = (n0 < FFN) ? n0 : n0 - FFN;
                    const int drow = 256 * (j / 128) + (j % 128) + ((n0 < FFN) ? 0 : 128);
                    transpose_item(w_ffn_in, 1024, 2 * FFN, WFI, 64 * kb, n0, drow, scr, lane); continue; } r -= I_FI;
                if (r < I_FO) { const int nb = r % 32, kb = r / 32; transpose_item(w_ffn_out, FFN, 1024, WFO, 64 * kb, 32 * nb, 32 * nb, scr, lane); continue; } r -= I_FO;
                { const int strip = r % 96, kc = r / 96; const int j = strip * 64 + lane; float a0 = 0.f, a1 = 0.f, a2 = 0.f;
                    for (int k = kc * 128; k < kc * 128 + 128; ++k) { const float w = w_mod[(size_t)k * 6144 + j];
                        const float c0 = c_prompt[k], c1 = c_prompt[1024 + k], c2 = c_sample[k];
                        a0 += c0 * pg8::sigm(c0) * w; a1 += c1 * pg8::sigm(c1) * w; a2 += c2 * pg8::sigm(c2) * w; }
                    MODP[(kc * 3 + 0) * 6144 + j] = a0; MODP[(kc * 3 + 1) * 6144 + j] = a1; MODP[(kc * 3 + 2) * 6144 + j] = a2; }
            }
        } else if (ph == 1 && !(DIS & 2)) {
            for (int i = blockIdx.x * NTHREADS + tid; i < 3 * 6144; i += G * NTHREADS) { float s = b_mod[i % 6144];
#pragma unroll
                for (int kc = 0; kc < 8; ++kc) s += MODP[kc * 3 * 6144 + i];
                MOD[i] = s; }
        } else if (ph >= 2) {
            const int pass = (ph - 2) / NSTEP, step = (ph - 2) % NSTEP;
            const float* xin = pass == 0 ? x_sample : x_prompt; float* outp = args.out + (pass == 0 ? (size_t)TP * D : 0);
            const int seqlen = pass == 0 ? 16384 : 8192, seq0 = pass == 0 ? 2 : 0, nseq = pass == 0 ? 1 : 2;
            bf16* QB = (bf16*)outp; bf16* KB = QB + (size_t)TP * 1024; bf16* TNA = QB; bf16* NKB = QB; bf16* NVT = KB;
            if ((step == ST_H || step == ST_HGN) && !(DIS & 4)) {
                h_rows(xin, MOD, g_pre_mix, step == ST_H ? HA : HB, seq0, seqlen, gw, NGW, lane);
                if (step == ST_HGN) {
                    for (int t = gw; t < TP; t += NGW) {
#pragma unroll
                        for (int h = 0; h < 4; ++h) { bf16* p = Ob + (size_t)t * 2048 + 512 * h + 8 * lane; float f[8]; pg8::unpack8(*(const u32x4*)p, f);
                            float s = 0.f;
#pragma unroll
                            for (int e = 0; e < 8; ++e) s += f[e];
                            const float mu = wave_sum(s) * (1.f / 512.f); float q = 0.f;
#pragma unroll
                            for (int e = 0; e < 8; ++e) { f[e] -= mu; q += f[e] * f[e]; }
                            const float rstd = 1.0f / sqrtf(wave_sum(q) * (1.f / 512.f) + EPS);
                            const f32x4 g0 = *(const f32x4*)(ret_gn + 512 * h + 8 * lane), g1 = *(const f32x4*)(ret_gn + 512 * h + 8 * lane + 4);
                            f[0] *= rstd * g0.x; f[1] *= rstd * g0.y; f[2] *= rstd * g0.z; f[3] *= rstd * g0.w; f[4] *= rstd * g1.x; f[5] *= rstd * g1.y; f[6] *= rstd * g1.z; f[7] *= rstd * g1.w;
                            *(u32x4*)p = pg8::pack8(f); }
                    }
                }
            } else if ((step == ST_G1N || step == ST_G1R || step == ST_GATES || step == ST_G2 || step == ST_G3 || step == ST_G5) && !(DIS & 8)) {
                const int nparts = (step == ST_G1N || step == ST_GATES) ? 2 : 1;
                for (int part = 0; part < nparts; ++part) {
                    pg8::Gemm g; pg8::EpiBf E; E.o0 = nullptr; E.o1 = nullptr; E.o2 = nullptr; E.a1 = nullptr; E.a2 = nullptr; E.ldo = 1024; E.ld1 = 2048; E.ld2 = 1024; E.seqmask = seqlen - 1;
                    int skip_at = 1 << 30, skip_by = 0;
                    if (step == ST_G1N) {
                        if (part == 0)         { g = pg8::Gemm{HA, WIN, TP, 2048, 1024}; E.mode = 0; E.o0 = NQ; E.o1 = NKB; }
                        else                   { g = pg8::Gemm{WIN + (size_t)2048 * 1024, HA, 4096, TP, 1024}; E.mode = 7; E.o0 = KT; E.o1 = VT; E.o2 = NVT; skip_at = 4; skip_by = 4; }
                    } else if (step == ST_G1R) { g = pg8::Gemm{HA, WIN + (size_t)3072 * 1024, TP, 2048, 1024}; E.mode = 1; E.o0 = QB; E.o1 = KB;
                    } else if (step == ST_GATES) {
                        if (part == 0)         { g = pg8::Gemm{HB, WIN + (size_t)9216 * 1024, TP, 2048, 1024}; E.mode = 2; E.o0 = SG; E.ldo = 2048; }
                        else                   { g = pg8::Gemm{HB, WIN + (size_t)7168 * 1024, TP, 2048, 1024}; E.mode = 3; E.o0 = Ob; E.ldo = 2048; E.a1 = Ob; E.ld1 = 2048; }
                    }
                    else if (step == ST_G2)    { g = pg8::Gemm{NQ, WNA, TP, 1024, 1024}; E.mode = 4; E.o0 = TNA; E.ldo = 1024; E.a1 = SG; E.ld1 = 2048; }
                    else if (step == ST_G3)    { g = pg8::Gemm{Ob, WRET, TP, 1024, 2048}; E.mode = 5; E.o0 = MERGED; E.ldo = 1024; E.a1 = SG + 1024; E.ld1 = 2048; E.a2 = TNA; E.ld2 = 1024; }
                    else                       { g = pg8::Gemm{H2, WFI, TP, 2 * FFN, 1024}; E.mode = 6; E.o0 = ACT; E.ldo = FFN; }
                    pg8::StaticOrder S; S.init(g.M, g.N, G, (int)blockIdx.x); S.skip_at = skip_at; S.skip_by = skip_by;
                    pg8::gemm_phase<pg8::EpiBf, pg8::StaticOrder, true, true>(lds, g, S, E);
                    if (part + 1 < nparts) { asm volatile("s_waitcnt vmcnt(0) lgkmcnt(0)" ::: "memory"); __syncthreads(); }
                }
            } else if ((step == ST_G4 || step == ST_G6) && !(DIS & 16)) {
                pg8::Gemm g; pg8::EpiF32 E;
                if (step == ST_G4) { g = pg8::Gemm{MERGED, WOUT, TP, 1024, 1024}; E.C = OUTMIX; E.ldc = 1024; }
                else               { g = pg8::Gemm{ACT, WFO, TP, 1024, FFN}; E.C = Fb; E.ldc = 1024; }
                pg8::StaticOrder S; S.init(g.M, g.N, G, (int)blockIdx.x);
                pg8::gemm_phase<pg8::EpiF32, pg8::StaticOrder, true, true>(lds, g, S, E);
            } else if (step == ST_NA && !(DIS & 32)) {
                na_mfma(lds, NQ, NKB, NVT, rpb, seqlen, tid, lane, wave, G);
            } else if (step == ST_R1 && !(DIS & 64)) {
#ifdef PROBE_COPY_O
                for (size_t i = (size_t)blockIdx.x * NTHREADS + tid; i < (size_t)TP * 2048 / 8; i += (size_t)G * NTHREADS) ((u32x4*)Ob)[i] = (i & 1) ? ((const u32x4*)QB)[i] : ((const u32x4*)VT)[i];
#elif defined(PROBE_ZERO_O)
                for (size_t i = (size_t)blockIdx.x * NTHREADS + tid; i < (size_t)TP * 2048 / 8; i += (size_t)G * NTHREADS) ((u32x4*)Ob)[i] = (u32x4){0u, 0u, 0u, 0u};
#else
#ifdef PROBE_R1_TWICE
                ret_intra(QB, KB, VT, Ob, decay_logit, lane, wave, G);
#endif
                ret_intra(QB, KB, VT, Ob, decay_logit, lane, wave, G);
#endif
            } else if (step == ST_R2A && !(DIS & 512)) {
                ret_scan<false>(lds, QB, KT, VT, Ob, (float*)(ws + WS_SCR), decay_logit, nseq, seqlen, tid, lane, wave, G);
            } else if (step == ST_R2 && !(DIS & 512)) {
                ret_scan<true>(lds, QB, KT, VT, Ob, (float*)(ws + WS_SCR), decay_logit, nseq, seqlen, tid, lane, wave, G);
            } else if (step == ST_N1 && !(DIS & 128)) {
                for (int t = gw; t < TP; t += NGW) { const float* mod = MOD + (size_t)(seq0 + t / seqlen) * 6144;
                    const f32x4* orow = (const f32x4*)(OUTMIX + (size_t)t * D) + lane; const f32x4* xr = (const f32x4*)(xin + (size_t)t * D) + lane; f32x4 v[4]; float ss = 0.f;
#pragma unroll
                    for (int j = 0; j < 4; ++j) { v[j] = orow[64 * j]; ss += (v[j].x * v[j].x + v[j].y * v[j].y) + (v[j].z * v[j].z + v[j].w * v[j].w); }
                    const float rstd = 1.0f / sqrtf(wave_sum(ss) * (1.f / D) + EPS); float s2 = 0.f;
                    f32x4* o4 = (f32x4*)(outp + (size_t)t * D) + lane;
#pragma unroll
                    for (int j = 0; j < 4; ++j) { const int c = 4 * lane + 256 * j; const f32x4 g = *(const f32x4*)(g_post_mix + c), gt = *(const f32x4*)(mod + 2048 + c);
                        v[j] = xr[64 * j] + gt * (v[j] * rstd * g); o4[64 * j] = v[j]; s2 += (v[j].x * v[j].x + v[j].y * v[j].y) + (v[j].z * v[j].z + v[j].w * v[j].w); }
                    const float rstd2 = 1.0f / sqrtf(wave_sum(s2) * (1.f / D) + EPS);
                    u32x2* o8 = (u32x2*)(H2 + (size_t)t * D) + lane;
#pragma unroll
                    for (int j = 0; j < 4; ++j) { const int c = 4 * lane + 256 * j; const f32x4 g = *(const f32x4*)(g_pre_ffn + c), sh = *(const f32x4*)(mod + 3072 + c), sc = *(const f32x4*)(mod + 4096 + c);
                        const f32x4 h = v[j] * rstd2 * g * (sc + 1.0f) + sh; u32x2 w; w.x = pk2(h.x, h.y); w.y = pk2(h.z, h.w); o8[64 * j] = w; }
                }
            } else if (step == ST_N2 && !(DIS & 256)) {
                for (int t = gw; t < TP; t += NGW) { const float* mod = MOD + (size_t)(seq0 + t / seqlen) * 6144;
                    const f32x4* frow = (const f32x4*)(Fb + (size_t)t * D) + lane; f32x4* o4 = (f32x4*)(outp + (size_t)t * D) + lane; f32x4 v[4]; float ss = 0.f;
#pragma unroll
                    for (int j = 0; j < 4; ++j) { v[j] = frow[64 * j]; ss += (v[j].x * v[j].x + v[j].y * v[j].y) + (v[j].z * v[j].z + v[j].w * v[j].w); }
                    const float rstd = 1.0f / sqrtf(wave_sum(ss) * (1.f / D) + EPS);
#pragma unroll
                    for (int j = 0; j < 4; ++j) { const int c = 4 * lane + 256 * j; const f32x4 g = *(const f32x4*)(g_post_ffn + c), gt = *(const f32x4*)(mod + 5120 + c);
                        o4[64 * j] = o4[64 * j] + gt * (v[j] * rstd * g); }
                }
            }
        }
    }
        if (ph + 1 < args.ph_hi) {
            if (ph == 0) cg::this_grid().sync();
            else { XcdBarrier bar; bar.bar = (unsigned*)(args.ws + WS_CTL) + CW_BAR; bar.x = xb_xcc_id(); bar.st = (volatile LAS unsigned*)(lds + MISC_OFF) + 8; xcd_barrier(bar); }
        }
    }
}

extern "C" void kernel_launch(void* const* d_in, const int* in_sizes, int n_in, void* d_out, int out_size, void* d_ws, size_t ws_size, hipStream_t stream) {
    static int grid = 0;
    if (grid == 0) {
        if (n_in != 19 || out_size != 2 * TP * D || ws_size < WS_END) { fprintf(stderr, "kernel_launch: unexpected shapes (n_in %d out %d ws %zu)\n", n_in, out_size, ws_size); grid = -1; return; }
        int dev = 0, cus = 0;
        if (hipGetDevice(&dev) != hipSuccess || hipDeviceGetAttribute(&cus, hipDeviceAttributeMultiprocessorCount, dev) != hipSuccess) { grid = -1; return; }
        if (hipFuncSetAttribute((const void*)fwd, hipFuncAttributeMaxDynamicSharedMemorySize, LDS_BYTES) != hipSuccess) { fprintf(stderr, "kernel_launch: hipFuncSetAttribute failed\n"); grid = -1; return; }
        grid = cus;
    }
    if (grid < 0) return;
    Args a{};
    for (int i = 0; i < 19; ++i) a.in[i] = (const float*)d_in[i];
    a.out = (float*)d_out; a.ws = (unsigned char*)d_ws;
#if ONE_LAUNCH
    if (hipMemsetAsync((char*)d_ws + WS_CTL, 0, CTL_ZERO_BYTES, stream) != hipSuccess) { fprintf(stderr, "kernel_launch: memset failed\n"); return; }
    a.ph_lo = 0; a.ph_hi = NPHASE;
    void* kargs[] = {&a};
    const hipError_t e = hipLaunchCooperativeKernel((const void*)fwd, dim3(grid), dim3(NTHREADS), kargs, LDS_BYTES, stream);
    if (e != hipSuccess) fprintf(stderr, "kernel_launch: cooperative launch failed: %s (grid %d)\n", hipGetErrorString(e), grid);
#else
    for (int ph = 0; ph < NPHASE; ++ph) { a.ph_lo = ph; a.ph_hi = ph + 1; hipLaunchKernelGGL(fwd, dim3(grid), dim3(NTHREADS), LDS_BYTES, stream, a); }
#endif
}
```
